# Optimizing an MI355X kernel written in HIP

```python
import jax, jax.numpy as jnp
from jax import lax
import numpy as np

D_MODEL = 2048
BATCH = 4
SEQ = 2048
DEPTH = 1

N_HEADS_A = 16
QK_NOPE = 64
QK_ROPE = 32
V_HEAD = 64
Q_LORA = 512
KV_LORA = 256
IDX_HEADS = 16
IDX_DIM = 64
IDX_ROPE = 32
TOPK_MAX = 256
Q_BLOCK = 128
ATT_WIDTH = N_HEADS_A * V_HEAD
CHUNK = 128
SGU_GROUPS = 8
SGU_GROUP_DIM = 128
SGU_WIDTH = SGU_GROUPS * SGU_GROUP_DIM
D_FF = -(-8 * D_MODEL // (3 * 256)) * 256
PLE_DIM = 256
ROPE_THETA = 10000.0
EPS = 1e-6

IN_SIZES = (Q_LORA, KV_LORA, QK_ROPE, IDX_DIM, IDX_HEADS, 2 * SGU_WIDTH, 2 * D_MODEL)
IN_COLS = sum(IN_SIZES)
IN_SPLITS = [int(c) for c in np.cumsum(IN_SIZES)[:-1]]

kernel_name = "hybrid_dsa_mla_gmlp_gated_block"


def rmsnorm(x, g):
    xf = x.astype(jnp.float32)
    y = xf * lax.rsqrt(jnp.mean(xf * xf, axis=-1, keepdims=True) + EPS)
    return (y * g.astype(jnp.float32)).astype(x.dtype)


def rope_tables(seq, dim):
    inv = ROPE_THETA ** (-jnp.arange(0, dim, 2, dtype=jnp.float32) / dim)
    ang = jnp.arange(seq, dtype=jnp.float32)[:, None] * inv[None, :]
    return jnp.cos(ang), jnp.sin(ang)


def apply_rope(x, cos, sin):
    half = x.shape[-1] // 2
    x1, x2 = x[..., :half], x[..., half:]
    c = cos.astype(x.dtype)
    s = sin.astype(x.dtype)
    return jnp.concatenate([x1 * c - x2 * s, x2 * c + x1 * s], axis=-1)


def rope_partial(x, cos, sin, r):
    return jnp.concatenate([apply_rope(x[..., :r], cos, sin), x[..., r:]], axis=-1)


def dsa_mla_attention(c_q, c_kv, k_rope_raw, k_idx_raw, w_idx_raw, w_uq, w_uk, w_iq):
    B, S, _ = c_q.shape
    cos_r, sin_r = rope_tables(S, QK_ROPE)
    cos_i, sin_i = rope_tables(S, IDX_ROPE)
    q = (c_q @ w_uq).reshape(B, S, N_HEADS_A, QK_NOPE + QK_ROPE)
    q_nope = q[..., :QK_NOPE]
    q_rope = apply_rope(q[..., QK_NOPE:], cos_r[:, None, :], sin_r[:, None, :])
    k_rope = apply_rope(k_rope_raw, cos_r, sin_r)
    q_lat = jnp.einsum('bshn,chn->bshc', q_nope, w_uk)
    q_idx = rope_partial((c_q @ w_iq).reshape(B, S, IDX_HEADS, IDX_DIM),
                         cos_i[:, None, :], sin_i[:, None, :], IDX_ROPE)
    k_idx = rope_partial(k_idx_raw, cos_i, sin_i, IDX_ROPE)
    w_idx = w_idx_raw * (IDX_HEADS ** -0.5 * IDX_DIM ** -0.5)
    topk = min(TOPK_MAX, S // 4)
    scale = (QK_NOPE + QK_ROPE) ** -0.5
    kpos = jnp.arange(S)

    def block(j):
        q0 = j * Q_BLOCK
        tpos = q0 + jnp.arange(Q_BLOCK)
        qi = lax.dynamic_slice_in_dim(q_idx, q0, Q_BLOCK, axis=1)
        wi = lax.dynamic_slice_in_dim(w_idx, q0, Q_BLOCK, axis=1)
        rel = jax.nn.relu(jnp.einsum('bqhd,bkd->bqhk', qi, k_idx))
        isc = jnp.einsum('bqhk,bqh->bqk', rel, wi).astype(jnp.float32)
        causal = kpos[None, :] <= tpos[:, None]
        isc = jnp.where(causal[None], isc, -jnp.inf)
        _, idx = lax.top_k(isc, topk)
        valid = idx <= tpos[None, :, None]
        c_sel = jax.vmap(lambda a, i: a[i])(c_kv, idx)
        r_sel = jax.vmap(lambda a, i: a[i])(k_rope, idx)
        ql = lax.dynamic_slice_in_dim(q_lat, q0, Q_BLOCK, axis=1)
        qr = lax.dynamic_slice_in_dim(q_rope, q0, Q_BLOCK, axis=1)
        s = (jnp.einsum('bqhc,bqkc->bqhk', ql, c_sel)
             + jnp.einsum('bqhr,bqkr->bqhk', qr, r_sel)).astype(jnp.float32) * scale
        s = jnp.where(valid[:, :, None, :], s, -jnp.inf)
        pr = jax.nn.softmax(s, axis=-1).astype(c_sel.dtype)
        return jnp.einsum('bqhk,bqkc->bqhc', pr, c_sel)

    o = lax.map(block, jnp.arange(S // Q_BLOCK))
    return jnp.moveaxis(o, 0, 1).reshape(B, S, N_HEADS_A, KV_LORA)


def chunked_sgu(uv, g_sgu, w_s, b_s):
    B, S, _ = uv.shape
    z = jax.nn.gelu(uv, approximate=False)
    u, v = z[..., :SGU_WIDTH], z[..., SGU_WIDTH:]
    v = rmsnorm(v, g_sgu).reshape(B, S // CHUNK, CHUNK, SGU_GROUPS, SGU_GROUP_DIM)
    mask = jnp.tril(jnp.ones((CHUNK, CHUNK), dtype=bool))
    w = jnp.where(mask[None], w_s, jnp.zeros_like(w_s))
    mixed = jnp.einsum('gts,bnsgc->bntgc', w, v) + jnp.transpose(b_s)[None, None, :, :, None]
    return u * mixed.reshape(B, S, SGU_WIDTH)


def setup_inputs(seed: int = 0) -> dict:
    key = jax.random.key(seed)
    ks = iter(jax.random.split(key, 32))
    f32 = jnp.float32

    def nrm(shape, fan_in):
        return jax.random.normal(next(ks), shape, f32) * (fan_in ** -0.5)

    def gain(shape):
        return 1.0 + 0.01 * jax.random.normal(next(ks), shape, f32)

    L = DEPTH
    return {
        "x": jax.random.normal(next(ks), (BATCH, SEQ, D_MODEL), f32),
        "p": jax.random.normal(next(ks), (DEPTH, BATCH, SEQ, PLE_DIM), f32),
        "g_mix": gain((L, D_MODEL)),
        "w_in": nrm((L, D_MODEL, IN_COLS), D_MODEL),
        "g_cq": gain((L, Q_LORA)),
        "g_ckv": gain((L, KV_LORA)),
        "w_uq": nrm((L, Q_LORA, N_HEADS_A * (QK_NOPE + QK_ROPE)), Q_LORA),
        "w_uk": nrm((L, KV_LORA, N_HEADS_A, QK_NOPE), KV_LORA),
        "w_uv": nrm((L, KV_LORA, N_HEADS_A, V_HEAD), KV_LORA),
        "w_iq": nrm((L, Q_LORA, IDX_HEADS * IDX_DIM), Q_LORA),
        "w_a_proj": nrm((L, ATT_WIDTH, D_MODEL), ATT_WIDTH),
        "g_sgu": gain((L, SGU_WIDTH)),
        "w_spatial": nrm((L, SGU_GROUPS, CHUNK, CHUNK), CHUNK),
        "b_spatial": gain((L, SGU_GROUPS, CHUNK)),
        "w_b_proj": nrm((L, SGU_WIDTH, D_MODEL), SGU_WIDTH),
        "w_o": nrm((L, D_MODEL, D_MODEL), D_MODEL),
        "g_ffn": gain((L, D_MODEL)),
        "w_gu": nrm((L, D_MODEL, 2 * D_FF), D_MODEL),
        "w_down": nrm((L, D_FF, D_MODEL), D_FF),
        "g_ple": gain((L, D_MODEL)),
        "w_ple_gate": nrm((L, D_MODEL, D_MODEL), D_MODEL),
        "w_ple_proj": nrm((L, PLE_DIM, D_MODEL), PLE_DIM),
        "g_final": gain((D_MODEL,)),
    }


def reference(x, p, g_mix, w_in, g_cq, g_ckv, w_uq, w_uk, w_uv, w_iq, w_a_proj,
              g_sgu, w_spatial, b_spatial, w_b_proj, w_o, g_ffn, w_gu, w_down,
              g_ple, w_ple_gate, w_ple_proj, g_final):
    B, S, _ = x.shape
    h = x
    for i in range(DEPTH):
        n = rmsnorm(h, g_mix[i])
        proj = n @ w_in[i]
        cq, ckv, kr, kidx, widx, uv, gates = jnp.split(proj, IN_SPLITS, axis=-1)
        c_q = rmsnorm(cq, g_cq[i])
        c_kv = rmsnorm(ckv, g_ckv[i])
        o_lat = dsa_mla_attention(c_q, c_kv, kr, kidx, widx, w_uq[i], w_uk[i], w_iq[i])
        o_a = jnp.einsum('bshc,chv->bshv', o_lat, w_uv[i]).reshape(B, S, ATT_WIDTH)
        y_a = o_a @ w_a_proj[i]
        y_b = chunked_sgu(uv, g_sgu[i], w_spatial[i], b_spatial[i]) @ w_b_proj[i]
        gg = jax.nn.sigmoid(gates)
        merged = gg[..., :D_MODEL] * y_a + gg[..., D_MODEL:] * y_b
        h = h + merged @ w_o[i]
        gu = rmsnorm(h, g_ffn[i]) @ w_gu[i]
        h = h + (jax.nn.silu(gu[..., :D_FF]) * gu[..., D_FF:]) @ w_down[i]
        ple_gate = jax.nn.sigmoid(rmsnorm(h, g_ple[i]) @ w_ple_gate[i])
        h = h + ple_gate * (p[i] @ w_ple_proj[i])
    return rmsnorm(h, g_final)
```

```cpp
#include <hip/hip_runtime.h>
#include <stdint.h>
#include <math.h>

namespace {
constexpr int B_ = 4, S_ = 2048, T_ = B_ * S_, D_ = 2048;
constexpr int NH = 16, NOPE = 64, ROPE = 32, QHD = NOPE + ROPE, QLORA = 512, KVL = 256;
constexpr int IH = 16, IDIM = 64, TOPK = 256;
constexpr int ATTW = 1024, SGW = 1024, CH = 128;
constexpr int DFF = 5632, PLE = 256, INC = 7024;
constexpr float EPS = 1e-6f;
constexpr int O_CQ = 0, O_CKV = 512, O_KR = 768, O_KIDX = 800, O_WIDX = 864, O_UV = 880, O_G = 2928;

template <int RND> __device__ __forceinline__ float rnd(float v) {
    if (RND == 1) { unsigned u = __float_as_uint(v); u = (u + 0x7fffu + ((u >> 16) & 1u)) & 0xffff0000u; return __uint_as_float(u); }
    if (RND == 2) { return (float)(_Float16)v; }
    return v;
}

template <int RND>
__global__ void __launch_bounds__(256) gemm_naive(const float* __restrict__ A, int lda, const float* __restrict__ Bm, int ldb,
                                                  float* __restrict__ C, int ldc, int M, int N, int K) {
    __shared__ float As[16][65];
    __shared__ float Bs[16][65];
    const int tx = threadIdx.x & 15, ty = threadIdx.x >> 4;
    const int m0 = blockIdx.y * 64, n0 = blockIdx.x * 64;
    float acc[4][4];
#pragma unroll
    for (int i = 0; i < 4; ++i)
#pragma unroll
        for (int j = 0; j < 4; ++j) acc[i][j] = 0.f;
    for (int k0 = 0; k0 < K; k0 += 16) {
#pragma unroll
        for (int r = 0; r < 4; ++r) {
            const int i = threadIdx.x + r * 256;
            const int m = i >> 4, k = i & 15;
            As[k][m] = rnd<RND>(A[(size_t)(m0 + m) * lda + k0 + k]);
            const int kb = i >> 6, n = i & 63;
            Bs[kb][n] = (n0 + n < N) ? rnd<RND>(Bm[(size_t)(k0 + kb) * ldb + n0 + n]) : 0.f;
        }
        __syncthreads();
#pragma unroll
        for (int k = 0; k < 16; ++k) {
            float a[4], b[4];
#pragma unroll
            for (int i = 0; i < 4; ++i) { a[i] = As[k][ty * 4 + i]; b[i] = Bs[k][tx * 4 + i]; }
#pragma unroll
            for (int i = 0; i < 4; ++i)
#pragma unroll
                for (int j = 0; j < 4; ++j) acc[i][j] = fmaf(a[i], b[j], acc[i][j]);
        }
        __syncthreads();
    }
#pragma unroll
    for (int i = 0; i < 4; ++i)
#pragma unroll
        for (int j = 0; j < 4; ++j) {
            const int n = n0 + tx * 4 + j;
            if (n < N) C[(size_t)(m0 + ty * 4 + i) * ldc + n] = acc[i][j];
        }
}

__global__ void __launch_bounds__(256) rmsnorm_k(const float* in, int ldi, float* out, int ldo, const float* __restrict__ g, int W) {
    __shared__ float red[4];
    const float* r = in + (size_t)blockIdx.x * ldi;
    float* o = out + (size_t)blockIdx.x * ldo;
    float v[8];
    float s = 0.f;
#pragma unroll
    for (int i = 0; i < 8; ++i) { const int c = threadIdx.x + i * 256; v[i] = (c < W) ? r[c] : 0.f; s += v[i] * v[i]; }
    for (int o2 = 32; o2 > 0; o2 >>= 1) s += __shfl_xor(s, o2);
    if ((threadIdx.x & 63) == 0) red[threadIdx.x >> 6] = s;
    __syncthreads();
    const float tot = red[0] + red[1] + red[2] + red[3];
    const float rs = rsqrtf(tot / (float)W + EPS);
#pragma unroll
    for (int i = 0; i < 8; ++i) { const int c = threadIdx.x + i * 256; if (c < W) o[c] = v[i] * rs * g[c]; }
}

__global__ void rope_k(float* buf, int nh, int hd, int off) {
    const int idx = blockIdx.x * blockDim.x + threadIdx.x;
    const int tot = T_ * nh * 16;
    if (idx >= tot) return;
    const int j = idx & 15, h = (idx >> 4) % nh, t = idx / (16 * nh);
    const int pos = t % S_;
    const float inv = powf(10000.0f, -(float)(2 * j) / 32.0f);
    const float ang = (float)pos * inv;
    const float c = cosf(ang), s = sinf(ang);
    float* p = buf + ((size_t)t * nh + h) * hd + off;
    const float x1 = p[j], x2 = p[j + 16];
    p[j] = x1 * c - x2 * s;
    p[j + 16] = x2 * c + x1 * s;
}

template <int RND>
__global__ void __launch_bounds__(256) isc_k(const float* __restrict__ qidx, const float* __restrict__ kidx, const float* __restrict__ widx, float* __restrict__ isc) {
    __shared__ float qs[IH * IDIM];
    __shared__ float ws[IH];
    const int t = blockIdx.x, b = t / S_, s = t % S_;
    for (int i = threadIdx.x; i < IH * IDIM; i += 256) qs[i] = rnd<RND>(qidx[(size_t)t * (IH * IDIM) + i]);
    if (threadIdx.x < IH) ws[threadIdx.x] = widx[(size_t)t * IH + threadIdx.x] * (1.0f / 32.0f);
    __syncthreads();
    for (int k = threadIdx.x; k <= s; k += 256) {
        const float* kr = kidx + (size_t)(b * S_ + k) * IDIM;
        float tot = 0.f;
        for (int h = 0; h < IH; ++h) {
            float d = 0.f;
            for (int i = 0; i < IDIM; ++i) d = fmaf(qs[h * IDIM + i], rnd<RND>(kr[i]), d);
            tot += ws[h] * fmaxf(d, 0.f);
        }
        isc[(size_t)t * S_ + k] = tot;
    }
}

__global__ void __launch_bounds__(256) topk_k(const float* __restrict__ isc, int* __restrict__ sel, int* __restrict__ cnt) {
    __shared__ float sc[S_];
    const int t = blockIdx.x, s = t % S_, n = s + 1;
    if (n <= TOPK) {
        if (threadIdx.x < n) sel[(size_t)t * TOPK + threadIdx.x] = threadIdx.x;
        if (threadIdx.x == 0) cnt[t] = n;
        return;
    }
    for (int i = threadIdx.x; i < n; i += 256) sc[i] = isc[(size_t)t * S_ + i];
    __syncthreads();
    for (int k = threadIdx.x; k < n; k += 256) {
        const float v = sc[k];
        int rank = 0;
        for (int j = 0; j < n; ++j) { const float w = sc[j]; rank += (w > v || (w == v && j < k)) ? 1 : 0; }
        if (rank < TOPK) sel[(size_t)t * TOPK + rank] = k;
    }
    if (threadIdx.x == 0) cnt[t] = TOPK;
}

__global__ void __launch_bounds__(256) attn_k(const float* __restrict__ q, const float* __restrict__ w_uk, const float* __restrict__ ckv,
                                              const float* __restrict__ krope, const int* __restrict__ sel, const int* __restrict__ cnt,
                                              const float* __restrict__ w_uv, float* __restrict__ oa) {
    __shared__ float ql[NH][KVL];
    __shared__ float qr[NH][ROPE];
    __shared__ float qn[NH][NOPE];
    __shared__ float pr[NH][TOPK];
    __shared__ int ks[TOPK];
    const int t = blockIdx.x, b = t / S_, tid = threadIdx.x;
    const int n = cnt[t];
    for (int i = tid; i < NH * QHD; i += 256) { const int h = i / QHD, d = i % QHD; const float v = q[(size_t)t * (NH * QHD) + i]; if (d < NOPE) qn[h][d] = v; else qr[h][d - NOPE] = v; }
    if (tid < n) ks[tid] = sel[(size_t)t * TOPK + tid];
    __syncthreads();
    for (int i = tid; i < NH * KVL; i += 256) {
        const int h = i / KVL, c = i % KVL;
        const float* w = w_uk + ((size_t)c * NH + h) * NOPE;
        float a = 0.f;
        for (int k = 0; k < NOPE; ++k) a = fmaf(qn[h][k], w[k], a);
        ql[h][c] = a;
    }
    __syncthreads();
    const float scale = 0.10206207261596575f;
    if (tid < n) {
        const int key = b * S_ + ks[tid];
        const float* cr = ckv + (size_t)key * KVL;
        const float* rr = krope + (size_t)key * ROPE;
        float sacc[NH];
#pragma unroll
        for (int h = 0; h < NH; ++h) sacc[h] = 0.f;
        for (int c = 0; c < KVL; ++c) { const float v = cr[c];
#pragma unroll
            for (int h = 0; h < NH; ++h) sacc[h] = fmaf(ql[h][c], v, sacc[h]); }
        for (int c = 0; c < ROPE; ++c) { const float v = rr[c];
#pragma unroll
            for (int h = 0; h < NH; ++h) sacc[h] = fmaf(qr[h][c], v, sacc[h]); }
#pragma unroll
        for (int h = 0; h < NH; ++h) pr[h][tid] = sacc[h] * scale;
    }
    __syncthreads();
    {
        const int wv = tid >> 6, lane = tid & 63;
        for (int hh = 0; hh < 4; ++hh) {
            const int h = wv * 4 + hh;
            float m = -INFINITY;
            for (int j = lane; j < n; j += 64) m = fmaxf(m, pr[h][j]);
            for (int o = 32; o > 0; o >>= 1) m = fmaxf(m, __shfl_xor(m, o));
            float sum = 0.f;
            for (int j = lane; j < n; j += 64) { const float e = __expf(pr[h][j] - m); pr[h][j] = e; sum += e; }
            for (int o = 32; o > 0; o >>= 1) sum += __shfl_xor(sum, o);
            const float inv = 1.0f / sum;
            for (int j = lane; j < n; j += 64) pr[h][j] *= inv;
        }
    }
    __syncthreads();
    {
        float o[NH];
#pragma unroll
        for (int h = 0; h < NH; ++h) o[h] = 0.f;
        for (int j = 0; j < n; ++j) {
            const float v = ckv[(size_t)(b * S_ + ks[j]) * KVL + tid];
#pragma unroll
            for (int h = 0; h < NH; ++h) o[h] = fmaf(pr[h][j], v, o[h]);
        }
        __syncthreads();
#pragma unroll
        for (int h = 0; h < NH; ++h) ql[h][tid] = o[h];
    }
    __syncthreads();
    for (int i = tid; i < NH * 64; i += 256) {
        const int h = i >> 6, v = i & 63;
        float a = 0.f;
        for (int c = 0; c < KVL; ++c) a = fmaf(ql[h][c], w_uv[((size_t)c * NH + h) * 64 + v], a);
        oa[(size_t)t * ATTW + i] = a;
    }
}

__global__ void gelu_k(float* buf, size_t n) {
    const size_t i = (size_t)blockIdx.x * blockDim.x + threadIdx.x;
    if (i < n) { const float x = buf[i]; buf[i] = 0.5f * x * (1.0f + erff(x * 0.70710678118654752f)); }
}

__global__ void __launch_bounds__(256) sgumix_k(const float* __restrict__ uv, const float* __restrict__ vn, const float* __restrict__ wsp,
                                                const float* __restrict__ bsp, float* __restrict__ sg) {
    const int t = blockIdx.x, tt = t % CH, t0 = t - tt;
    for (int ch = threadIdx.x; ch < SGW; ch += 256) {
        const int g = ch / 128;
        const float* w = wsp + ((size_t)g * CH + tt) * CH;
        float a = 0.f;
        for (int ss = 0; ss <= tt; ++ss) a = fmaf(w[ss], vn[(size_t)(t0 + ss) * SGW + ch], a);
        a += bsp[g * CH + tt];
        sg[(size_t)t * SGW + ch] = uv[(size_t)t * (2 * SGW) + ch] * a;
    }
}

__device__ __forceinline__ float sigm(float x) { return 1.0f / (1.0f + __expf(-x)); }

__global__ void merge_k(const float* __restrict__ gates, const float* __restrict__ ya, const float* __restrict__ yb, float* __restrict__ out) {
    const size_t i = (size_t)blockIdx.x * blockDim.x + threadIdx.x;
    if (i >= (size_t)T_ * D_) return;
    const size_t t = i / D_, c = i % D_;
    out[i] = sigm(gates[t * (2 * D_) + c]) * ya[i] + sigm(gates[t * (2 * D_) + D_ + c]) * yb[i];
}
__global__ void add_k(const float* __restrict__ a, const float* __restrict__ b, float* __restrict__ out, size_t n) {
    const size_t i = (size_t)blockIdx.x * blockDim.x + threadIdx.x;
    if (i < n) out[i] = a[i] + b[i];
}
__global__ void swiglu_k(const float* __restrict__ gu, float* __restrict__ act, int rows) {
    const size_t i = (size_t)blockIdx.x * blockDim.x + threadIdx.x;
    if (i >= (size_t)rows * DFF) return;
    const size_t r = i / DFF, c = i % DFF;
    const float g = gu[r * (2 * DFF) + c], u = gu[r * (2 * DFF) + DFF + c];
    act[i] = g * sigm(g) * u;
}
__global__ void ple_k(const float* __restrict__ h2, const float* __restrict__ gl, const float* __restrict__ pp, float* __restrict__ out, size_t n) {
    const size_t i = (size_t)blockIdx.x * blockDim.x + threadIdx.x;
    if (i < n) out[i] = h2[i] + sigm(gl[i]) * pp[i];
}

template <int RND>
void gemm(hipStream_t st, const float* A, int lda, const float* Bm, int ldb, float* C, int ldc, int M, int N, int K) {
    dim3 grid((N + 63) / 64, M / 64);
    hipLaunchKernelGGL(gemm_naive<RND>, grid, dim3(256), 0, st, A, lda, Bm, ldb, C, ldc, M, N, K);
}
}

#ifndef RND_IDX
#define RND_IDX 0
#endif
#ifndef RND_MAIN
#define RND_MAIN 0
#endif

extern "C" void kernel_launch(void* const* d_in, const int* in_sizes, int n_in, void* d_out, int out_size, void* d_ws, size_t ws_size, hipStream_t stream) {
    const float* x = (const float*)d_in[0];      const float* p = (const float*)d_in[1];
    const float* g_mix = (const float*)d_in[2];  const float* w_in = (const float*)d_in[3];
    const float* g_cq = (const float*)d_in[4];   const float* g_ckv = (const float*)d_in[5];
    const float* w_uq = (const float*)d_in[6];   const float* w_uk = (const float*)d_in[7];
    const float* w_uv = (const float*)d_in[8];   const float* w_iq = (const float*)d_in[9];
    const float* w_a = (const float*)d_in[10];   const float* g_sgu = (const float*)d_in[11];
    const float* w_sp = (const float*)d_in[12];  const float* b_sp = (const float*)d_in[13];
    const float* w_b = (const float*)d_in[14];   const float* w_o = (const float*)d_in[15];
    const float* g_ffn = (const float*)d_in[16]; const float* w_gu = (const float*)d_in[17];
    const float* w_down = (const float*)d_in[18]; const float* g_ple = (const float*)d_in[19];
    const float* w_pg = (const float*)d_in[20];  const float* w_pp = (const float*)d_in[21];
    const float* g_fin = (const float*)d_in[22];
    float* out = (float*)d_out;
    char* ws = (char*)d_ws;
    const size_t MiB = 1u << 20;
    auto F = [&](double off) { return (float*)(ws + (size_t)(off * MiB)); };
    hipStream_t st = stream;
    const size_t NTD = (size_t)T_ * D_;
    const int EB = 256;
    auto nb = [&](size_t n) { return (unsigned)((n + EB - 1) / EB); };

    float* n_ = F(0);
    float *cq = F(64), *ckv = F(80), *kr = F(88), *kidx = F(89), *widx = F(91), *uv = F(92), *gates = F(156);
    hipLaunchKernelGGL(rmsnorm_k, dim3(T_), dim3(256), 0, st, x, D_, n_, D_, g_mix, D_);
    gemm<RND_IDX>(st, n_, D_, w_in + O_CQ, INC, cq, QLORA, T_, QLORA, D_);
    gemm<RND_MAIN>(st, n_, D_, w_in + O_CKV, INC, ckv, KVL, T_, KVL, D_);
    gemm<RND_MAIN>(st, n_, D_, w_in + O_KR, INC, kr, ROPE, T_, ROPE, D_);
    gemm<RND_IDX>(st, n_, D_, w_in + O_KIDX, INC, kidx, IDIM, T_, IDIM, D_);
    gemm<RND_IDX>(st, n_, D_, w_in + O_WIDX, INC, widx, IH, T_, IH, D_);
    gemm<RND_MAIN>(st, n_, D_, w_in + O_UV, INC, uv, 2 * SGW, T_, 2 * SGW, D_);
    gemm<RND_MAIN>(st, n_, D_, w_in + O_G, INC, gates, 2 * D_, T_, 2 * D_, D_);
    float *c_q = F(284), *c_kv = F(300);
    hipLaunchKernelGGL(rmsnorm_k, dim3(T_), dim3(256), 0, st, cq, QLORA, c_q, QLORA, g_cq, QLORA);
    hipLaunchKernelGGL(rmsnorm_k, dim3(T_), dim3(256), 0, st, ckv, KVL, c_kv, KVL, g_ckv, KVL);
    hipLaunchKernelGGL(rope_k, dim3(nb((size_t)T_ * 16)), dim3(EB), 0, st, kr, 1, ROPE, 0);
    hipLaunchKernelGGL(rope_k, dim3(nb((size_t)T_ * 16)), dim3(EB), 0, st, kidx, 1, IDIM, 0);
    float *q = F(0), *qidx = F(308);
    gemm<RND_MAIN>(st, c_q, QLORA, w_uq, NH * QHD, q, NH * QHD, T_, NH * QHD, QLORA);
    gemm<RND_IDX>(st, c_q, QLORA, w_iq, IH * IDIM, qidx, IH * IDIM, T_, IH * IDIM, QLORA);
    hipLaunchKernelGGL(rope_k, dim3(nb((size_t)T_ * NH * 16)), dim3(EB), 0, st, q, NH, QHD, NOPE);
    hipLaunchKernelGGL(rope_k, dim3(nb((size_t)T_ * IH * 16)), dim3(EB), 0, st, qidx, IH, IDIM, 0);
    float* isc = out;
    int* sel = (int*)F(340); int* cnt = (int*)F(348);
    hipLaunchKernelGGL(isc_k<RND_IDX>, dim3(T_), dim3(256), 0, st, qidx, kidx, widx, isc);
    hipLaunchKernelGGL(topk_k, dim3(T_), dim3(256), 0, st, isc, sel, cnt);
    float* oa = F(48);
    hipLaunchKernelGGL(attn_k, dim3(T_), dim3(256), 0, st, q, w_uk, c_kv, kr, sel, cnt, w_uv, oa);
    float* ya = out;
    gemm<RND_MAIN>(st, oa, ATTW, w_a, D_, ya, D_, T_, D_, ATTW);
    hipLaunchKernelGGL(gelu_k, dim3(nb((size_t)T_ * 2 * SGW)), dim3(EB), 0, st, uv, (size_t)T_ * 2 * SGW);
    float* vn = F(0);
    hipLaunchKernelGGL(rmsnorm_k, dim3(T_), dim3(256), 0, st, uv + SGW, 2 * SGW, vn, SGW, g_sgu, SGW);
    float* sg = F(308);
    hipLaunchKernelGGL(sgumix_k, dim3(T_), dim3(256), 0, st, uv, vn, w_sp, b_sp, sg);
    float* yb = F(0);
    gemm<RND_MAIN>(st, sg, SGW, w_b, D_, yb, D_, T_, D_, SGW);
    float* merged = F(92);
    hipLaunchKernelGGL(merge_k, dim3(nb(NTD)), dim3(EB), 0, st, gates, ya, yb, merged);
    float* tmp = F(0);
    gemm<RND_MAIN>(st, merged, D_, w_o, D_, tmp, D_, T_, D_, D_);
    float* h1 = out;
    hipLaunchKernelGGL(add_k, dim3(nb(NTD)), dim3(EB), 0, st, x, tmp, h1, NTD);
    float* hn = F(284);
    hipLaunchKernelGGL(rmsnorm_k, dim3(T_), dim3(256), 0, st, h1, D_, hn, D_, g_ffn, D_);
    float *act = F(0), *guc = F(176);
    for (int c = 0; c < 4; ++c) {
        gemm<RND_MAIN>(st, hn + (size_t)c * 2048 * D_, D_, w_gu, 2 * DFF, guc, 2 * DFF, 2048, 2 * DFF, D_);
        hipLaunchKernelGGL(swiglu_k, dim3(nb((size_t)2048 * DFF)), dim3(EB), 0, st, guc, act + (size_t)c * 2048 * DFF, 2048);
    }
    float* tmp2 = F(264);
    gemm<RND_MAIN>(st, act, DFF, w_down, D_, tmp2, D_, T_, D_, DFF);
    hipLaunchKernelGGL(add_k, dim3(nb(NTD)), dim3(EB), 0, st, h1, tmp2, h1, NTD);
    float *hn2 = F(0), *gl = F(64), *pp = F(128);
    hipLaunchKernelGGL(rmsnorm_k, dim3(T_), dim3(256), 0, st, h1, D_, hn2, D_, g_ple, D_);
    gemm<RND_MAIN>(st, hn2, D_, w_pg, D_, gl, D_, T_, D_, D_);
    gemm<RND_MAIN>(st, p, PLE, w_pp, D_, pp, D_, T_, D_, PLE);
    hipLaunchKernelGGL(ple_k, dim3(nb(NTD)), dim3(EB), 0, st, h1, gl, pp, h1, NTD);
    hipLaunchKernelGGL(rmsnorm_k, dim3(T_), dim3(256), 0, st, h1, D_, out, D_, g_fin, D_);
}
```

```cpp
#include <hip/hip_runtime.h>
#include <stdint.h>
#include <math.h>
#include <cstdio>

#define LAS __attribute__((address_space(3)))
#define GAS __attribute__((address_space(1)))
typedef unsigned short u16;
typedef short s16x8 __attribute__((ext_vector_type(8)));
typedef _Float16 h16x8 __attribute__((ext_vector_type(8)));
typedef float f32x4 __attribute__((ext_vector_type(4)));
typedef float f32x2 __attribute__((ext_vector_type(2)));
typedef unsigned u32x4 __attribute__((ext_vector_type(4)));
typedef unsigned u32x2 __attribute__((ext_vector_type(2)));

namespace {
constexpr int B_ = 4, S_ = 2048, T_ = B_ * S_, D_ = 2048;
constexpr int NH = 16, NOPE = 64, ROPE = 32, QHD = NOPE + ROPE, QLORA = 512, KVL = 256;
constexpr int IH = 16, IDIM = 64, TOPK = 256;
constexpr int ATTW = 1024, SGW = 1024, CH = 128;
constexpr int DFF = 5632, PLE = 256, INC = 7024;
constexpr float EPS = 1e-6f;
constexpr int O_CQ = 0, O_CKV = 512, O_KR = 768, O_KIDX = 800, O_WIDX = 864, O_UV = 880, O_G = 2928;
constexpr int CR = 128;

template <int RND> __device__ __forceinline__ float rnd(float v) {
    if (RND == 1) { unsigned u = __float_as_uint(v); u = (u + 0x7fffu + ((u >> 16) & 1u)) & 0xffff0000u; return __uint_as_float(u); }
    if (RND == 2) { return (float)(_Float16)v; }
    return v;
}
template <int RND>
__global__ void __launch_bounds__(256) gemm_naive(const float* __restrict__ A, int lda, const float* __restrict__ Bm, int ldb,
                                                  float* __restrict__ C, int ldc, int M, int N, int K) {
    __shared__ float As[16][65];
    __shared__ float Bs[16][65];
    const int tx = threadIdx.x & 15, ty = threadIdx.x >> 4;
    const int m0 = blockIdx.y * 64, n0 = blockIdx.x * 64;
    float acc[4][4];
#pragma unroll
    for (int i = 0; i < 4; ++i)
#pragma unroll
        for (int j = 0; j < 4; ++j) acc[i][j] = 0.f;
    for (int k0 = 0; k0 < K; k0 += 16) {
#pragma unroll
        for (int r = 0; r < 4; ++r) {
            const int i = threadIdx.x + r * 256;
            const int m = i >> 4, k = i & 15;
            As[k][m] = rnd<RND>(A[(size_t)(m0 + m) * lda + k0 + k]);
            const int kb = i >> 6, n = i & 63;
            Bs[kb][n] = (n0 + n < N) ? rnd<RND>(Bm[(size_t)(k0 + kb) * ldb + n0 + n]) : 0.f;
        }
        __syncthreads();
#pragma unroll
        for (int k = 0; k < 16; ++k) {
            float a[4], b[4];
#pragma unroll
            for (int i = 0; i < 4; ++i) { a[i] = As[k][ty * 4 + i]; b[i] = Bs[k][tx * 4 + i]; }
#pragma unroll
            for (int i = 0; i < 4; ++i)
#pragma unroll
                for (int j = 0; j < 4; ++j) acc[i][j] = fmaf(a[i], b[j], acc[i][j]);
        }
        __syncthreads();
    }
#pragma unroll
    for (int i = 0; i < 4; ++i)
#pragma unroll
        for (int j = 0; j < 4; ++j) {
            const int n = n0 + tx * 4 + j;
            if (n < N) C[(size_t)(m0 + ty * 4 + i) * ldc + n] = acc[i][j];
        }
}
__global__ void __launch_bounds__(256) rmsnorm_k(const float* in, int ldi, float* out, int ldo, const float* __restrict__ g, int W) {
    __shared__ float red[4];
    const float* r = in + (size_t)blockIdx.x * ldi;
    float* o = out + (size_t)blockIdx.x * ldo;
    float v[8];
    float s = 0.f;
#pragma unroll
    for (int i = 0; i < 8; ++i) { const int c = threadIdx.x + i * 256; v[i] = (c < W) ? r[c] : 0.f; s += v[i] * v[i]; }
    for (int o2 = 32; o2 > 0; o2 >>= 1) s += __shfl_xor(s, o2);
    if ((threadIdx.x & 63) == 0) red[threadIdx.x >> 6] = s;
    __syncthreads();
    const float tot = red[0] + red[1] + red[2] + red[3];
    const float rs = rsqrtf(tot / (float)W + EPS);
#pragma unroll
    for (int i = 0; i < 8; ++i) { const int c = threadIdx.x + i * 256; if (c < W) o[c] = v[i] * rs * g[c]; }
}
__global__ void rope_k(float* buf, int nh, int hd, int off, int rows, int t_base) {
    const int idx = blockIdx.x * blockDim.x + threadIdx.x;
    const int tot = rows * nh * 16;
    if (idx >= tot) return;
    const int j = idx & 15, h = (idx >> 4) % nh, t = idx / (16 * nh);
    const int pos = (t_base + t) % S_;
    const float inv = powf(10000.0f, -(float)(2 * j) / 32.0f);
    const float ang = (float)pos * inv;
    const float c = cosf(ang), s = sinf(ang);
    float* p = buf + ((size_t)t * nh + h) * hd + off;
    const float x1 = p[j], x2 = p[j + 16];
    p[j] = x1 * c - x2 * s;
    p[j + 16] = x2 * c + x1 * s;
}
template <int RND>
__global__ void __launch_bounds__(256) isc_k(const float* __restrict__ qidx, const float* __restrict__ kidxF, const float* __restrict__ widx, float* __restrict__ isc, int t_base) {
    __shared__ float qs[IH * IDIM];
    __shared__ float ws[IH];
    const int lr = blockIdx.x, t = t_base + lr, b = t / S_, s = t % S_;
    for (int i = threadIdx.x; i < IH * IDIM; i += 256) qs[i] = rnd<RND>(qidx[(size_t)lr * (IH * IDIM) + i]);
    if (threadIdx.x < IH) ws[threadIdx.x] = widx[(size_t)lr * IH + threadIdx.x] * (1.0f / 32.0f);
    __syncthreads();
    for (int k = threadIdx.x; k <= s; k += 256) {
        const float* kr = kidxF + (size_t)(b * S_ + k) * IDIM;
        float tot = 0.f;
        for (int h = 0; h < IH; ++h) {
            float d = 0.f;
            for (int i = 0; i < IDIM; ++i) d = fmaf(qs[h * IDIM + i], rnd<RND>(kr[i]), d);
            tot += ws[h] * fmaxf(d, 0.f);
        }
        isc[(size_t)lr * S_ + k] = tot;
    }
}
__global__ void __launch_bounds__(256) topk_k(const float* __restrict__ isc, int* __restrict__ sel, int* __restrict__ cnt, int t_base) {
    __shared__ float sc[S_];
    const int lr = blockIdx.x, t = t_base + lr, s = t % S_, n = s + 1;
    if (n <= TOPK) {
        if (threadIdx.x < n) sel[(size_t)lr * TOPK + threadIdx.x] = threadIdx.x;
        if (threadIdx.x == 0) cnt[lr] = n;
        return;
    }
    for (int i = threadIdx.x; i < n; i += 256) sc[i] = isc[(size_t)lr * S_ + i];
    __syncthreads();
    for (int k = threadIdx.x; k < n; k += 256) {
        const float v = sc[k];
        int rank = 0;
        for (int j = 0; j < n; ++j) { const float w = sc[j]; rank += (w > v || (w == v && j < k)) ? 1 : 0; }
        if (rank < TOPK) sel[(size_t)lr * TOPK + rank] = k;
    }
    if (threadIdx.x == 0) cnt[lr] = TOPK;
}
__global__ void __launch_bounds__(256) attn_k(const float* __restrict__ q, const float* __restrict__ w_uk, const float* __restrict__ ckvF,
                                              const float* __restrict__ kropeF, const int* __restrict__ sel, const int* __restrict__ cnt,
                                              const float* __restrict__ w_uv, float* __restrict__ oa, int t_base) {
    __shared__ float ql[NH][KVL];
    __shared__ float qr[NH][ROPE];
    __shared__ float qn[NH][NOPE];
    __shared__ float pr[NH][TOPK];
    __shared__ int ks[TOPK];
    const int lr = blockIdx.x, t = t_base + lr, b = t / S_, tid = threadIdx.x;
    const int n = cnt[lr];
    for (int i = tid; i < NH * QHD; i += 256) { const int h = i / QHD, d = i % QHD; const float v = q[(size_t)lr * (NH * QHD) + i]; if (d < NOPE) qn[h][d] = v; else qr[h][d - NOPE] = v; }
    if (tid < n) ks[tid] = sel[(size_t)lr * TOPK + tid];
    __syncthreads();
    for (int i = tid; i < NH * KVL; i += 256) {
        const int h = i / KVL, c = i % KVL;
        const float* w = w_uk + ((size_t)c * NH + h) * NOPE;
        float a = 0.f;
        for (int k = 0; k < NOPE; ++k) a = fmaf(qn[h][k], w[k], a);
        ql[h][c] = a;
    }
    __syncthreads();
    const float scale = 0.10206207261596575f;
    if (tid < n) {
        const int key = b * S_ + ks[tid];
        const float* cr = ckvF + (size_t)key * KVL;
        const float* rr = kropeF + (size_t)key * ROPE;
        float sacc[NH];
#pragma unroll
        for (int h = 0; h < NH; ++h) sacc[h] = 0.f;
        for (int c = 0; c < KVL; ++c) { const float v = cr[c];
#pragma unroll
            for (int h = 0; h < NH; ++h) sacc[h] = fmaf(ql[h][c], v, sacc[h]); }
        for (int c = 0; c < ROPE; ++c) { const float v = rr[c];
#pragma unroll
            for (int h = 0; h < NH; ++h) sacc[h] = fmaf(qr[h][c], v, sacc[h]); }
#pragma unroll
        for (int h = 0; h < NH; ++h) pr[h][tid] = sacc[h] * scale;
    }
    __syncthreads();
    {
        const int wv = tid >> 6, lane = tid & 63;
        for (int hh = 0; hh < 4; ++hh) {
            const int h = wv * 4 + hh;
            float m = -INFINITY;
            for (int j = lane; j < n; j += 64) m = fmaxf(m, pr[h][j]);
            for (int o = 32; o > 0; o >>= 1) m = fmaxf(m, __shfl_xor(m, o));
            float sum = 0.f;
            for (int j = lane; j < n; j += 64) { const float e = __expf(pr[h][j] - m); pr[h][j] = e; sum += e; }
            for (int o = 32; o > 0; o >>= 1) sum += __shfl_xor(sum, o);
            const float inv = 1.0f / sum;
            for (int j = lane; j < n; j += 64) pr[h][j] *= inv;
        }
    }
    __syncthreads();
    {
        float o[NH];
#pragma unroll
        for (int h = 0; h < NH; ++h) o[h] = 0.f;
        for (int j = 0; j < n; ++j) {
            const float v = ckvF[(size_t)(b * S_ + ks[j]) * KVL + tid];
#pragma unroll
            for (int h = 0; h < NH; ++h) o[h] = fmaf(pr[h][j], v, o[h]);
        }
        __syncthreads();
#pragma unroll
        for (int h = 0; h < NH; ++h) ql[h][tid] = o[h];
    }
    __syncthreads();
    for (int i = tid; i < NH * 64; i += 256) {
        const int h = i >> 6, v = i & 63;
        float a = 0.f;
        for (int c = 0; c < KVL; ++c) a = fmaf(ql[h][c], w_uv[((size_t)c * NH + h) * 64 + v], a);
        oa[(size_t)lr * ATTW + i] = a;
    }
}
__global__ void gelu_k(float* buf, size_t n) {
    const size_t i = (size_t)blockIdx.x * blockDim.x + threadIdx.x;
    if (i < n) { const float x = buf[i]; buf[i] = 0.5f * x * (1.0f + erff(x * 0.70710678118654752f)); }
}
__global__ void __launch_bounds__(256) sgumix_k(const float* __restrict__ uv, const float* __restrict__ vn, const float* __restrict__ wsp,
                                                const float* __restrict__ bsp, float* __restrict__ sg) {
    const int t = blockIdx.x, tt = t % CH, t0 = t - tt;
    for (int ch = threadIdx.x; ch < SGW; ch += 256) {
        const int g = ch / 128;
        const float* w = wsp + ((size_t)g * CH + tt) * CH;
        float a = 0.f;
        for (int ss = 0; ss <= tt; ++ss) a = fmaf(w[ss], vn[(size_t)(t0 + ss) * SGW + ch], a);
        a += bsp[g * CH + tt];
        sg[(size_t)t * SGW + ch] = uv[(size_t)t * (2 * SGW) + ch] * a;
    }
}
__device__ __forceinline__ float sigm(float x) { return 1.0f / (1.0f + __expf(-x)); }
__global__ void merge_k(const float* __restrict__ gates, const float* __restrict__ ya, const float* __restrict__ yb, float* __restrict__ out, size_t n) {
    const size_t i = (size_t)blockIdx.x * blockDim.x + threadIdx.x;
    if (i >= n) return;
    const size_t t = i / D_, c = i % D_;
    out[i] = sigm(gates[t * (2 * D_) + c]) * ya[i] + sigm(gates[t * (2 * D_) + D_ + c]) * yb[i];
}
__global__ void add_k(const float* __restrict__ a, const float* __restrict__ b, float* __restrict__ out, size_t n) {
    const size_t i = (size_t)blockIdx.x * blockDim.x + threadIdx.x;
    if (i < n) out[i] = a[i] + b[i];
}
__global__ void swiglu_k(const float* __restrict__ gu, float* __restrict__ act, int rows) {
    const size_t i = (size_t)blockIdx.x * blockDim.x + threadIdx.x;
    if (i >= (size_t)rows * DFF) return;
    const size_t r = i / DFF, c = i % DFF;
    const float g = gu[r * (2 * DFF) + c], u = gu[r * (2 * DFF) + DFF + c];
    act[i] = g * sigm(g) * u;
}
template <int RND>
void gemm(hipStream_t st, const float* A, int lda, const float* Bm, int ldb, float* C, int ldc, int M, int N, int K) {
    dim3 grid((N + 63) / 64, M / 64);
    hipLaunchKernelGGL(gemm_naive<RND>, grid, dim3(256), 0, st, A, lda, Bm, ldb, C, ldc, M, N, K);
}

__device__ __forceinline__ unsigned f2bf(float f) { unsigned u = __float_as_uint(f); return (u + 0x7fffu + ((u >> 16) & 1u)) >> 16; }
__global__ void __launch_bounds__(256) shim_row_bf16_sq(const float* __restrict__ src, int lds_, u16* __restrict__ dst, int ldd, float* __restrict__ rowsq, int W) {
    __shared__ float red[4];
    const float* r = src + (size_t)blockIdx.x * lds_;
    u16* o = dst + (size_t)blockIdx.x * ldd;
    float s = 0.f;
    for (int c = threadIdx.x; c < W; c += 256) { const float v = r[c]; s += v * v; o[c] = (u16)f2bf(v); }
    for (int o2 = 32; o2 > 0; o2 >>= 1) s += __shfl_xor(s, o2);
    if ((threadIdx.x & 63) == 0) red[threadIdx.x >> 6] = s;
    __syncthreads();
    if (threadIdx.x == 0 && rowsq) rowsq[blockIdx.x] = red[0] + red[1] + red[2] + red[3];
}

constexpr size_t MiB = 1u << 20;
constexpr size_t WS_WIN = 0 * MiB, WS_WQ = 28 * MiB, WS_WA = 34 * MiB, WS_WB = 38 * MiB, WS_WO = 42 * MiB, WS_WUV = 50 * MiB;
constexpr size_t WS_ROPE = 51 * MiB;
constexpr size_t WS_RSQV = 51 * MiB + 256 * 1024, WS_RSQ1 = WS_RSQV + 32768, WS_RSQ2 = WS_RSQ1 + 32768, WS_RSQ3 = WS_RSQ2 + 32768;
constexpr size_t WS_P16 = 52 * MiB, WS_CTL = 56 * MiB, CTL_BYTES = 65536;
constexpr size_t WS_N16 = 60 * MiB, WS_OA = 60 * MiB, WS_H2B = 60 * MiB, WS_MERGED = 76 * MiB;
constexpr size_t WS_Z = 92 * MiB, WS_RAW = 124 * MiB, WS_OLAT = 92 * MiB, WS_WGU = 108 * MiB;
constexpr size_t WS_WDN = 152 * MiB, WS_WPG = 174 * MiB, WS_WPP = 182 * MiB;
constexpr size_t WS_S = 156 * MiB, WS_CQ = 172 * MiB, WS_KV = 180 * MiB, WS_KIDX = 185 * MiB, WS_WIDX = 186 * MiB, WS_SEL = 187 * MiB;
constexpr size_t WS_QIDX = 191 * MiB, WS_Q = 207 * MiB, WS_TMP = 207 * MiB, WS_H1B = 183 * MiB, WS_ACT = 215 * MiB, WS_PP = 183 * MiB;
constexpr size_t WS_ARENA = 312 * MiB, WS_END = 352 * MiB;

typedef __bf16 bf16x2_t __attribute__((ext_vector_type(2)));
__device__ __forceinline__ unsigned cvt_pk_bf16(float lo, float hi) { bf16x2_t v; v.x = (__bf16)lo; v.y = (__bf16)hi; return __builtin_bit_cast(unsigned, v); }
__device__ __forceinline__ unsigned cvt_pk_f16(float lo, float hi) { const _Float16 a = (_Float16)lo, b = (_Float16)hi; return (unsigned)__builtin_bit_cast(unsigned short, a) | ((unsigned)__builtin_bit_cast(unsigned short, b) << 16); }
__device__ __forceinline__ float bf_lo(unsigned w) { return __uint_as_float(w << 16); }
__device__ __forceinline__ float bf_hi(unsigned w) { return __uint_as_float(w & 0xffff0000u); }
__device__ __forceinline__ float sigmoidf_(float x) { return __builtin_amdgcn_rcpf(1.0f + __builtin_amdgcn_exp2f(-1.4426950408889634f * x)); }

namespace pg8 {
constexpr int BM = 256, BK = 64, HALF = 128, HTB = HALF * BK * 2, STAGE_BYTES = 8 * HTB, NXCD = 8, WGM = 8;
__device__ __forceinline__ int lds_byte(int r, int c) { const int st = (r >> 4) * 2 + (c >> 5), rr = r & 15, cc = c & 31, ob = rr * 64 + cc * 2; return st * 1024 + (ob ^ (((ob >> 9) & 1) << 5)); }
__device__ __forceinline__ void stage_rc(int b, int& R, int& C) { const int st = b / 1024, sb = b % 1024, swz = sb ^ (((sb >> 9) & 1) << 5); R = (st >> 1) * 16 + swz / 64; C = (st & 1) * 32 + (swz % 64) / 2; }
__device__ __forceinline__ int perm32(int rho) { const int n = rho >> 4, i = rho & 15; return 8 * (i >> 2) + 4 * n + (i & 3); }

struct Unit { const char* A; const char* B; int pm, pn, nt, kind; };

struct TileOrder {
    int nM, nN, nwg, G, c;
    __device__ __forceinline__ void init(int nM_, int nN_, int G_, int c_) { nM = nM_; nN = nN_; nwg = nM * nN; G = G_; c = c_; }
    __device__ __forceinline__ bool next(int i, int& pm, int& pn) const {
        const long L = (long)i * G + c; if (L >= nwg) return false;
        int wgid = (int)L; { const int q = nwg / NXCD, r = nwg % NXCD, xcd = wgid % NXCD, off = wgid / NXCD; wgid = (xcd < r ? xcd * (q + 1) : r * (q + 1) + (xcd - r) * q) + off; }
        const int nig = WGM * nN, gid = wgid / nig, fm = gid * WGM, gsz = (nM - fm) < WGM ? (nM - fm) : WGM;
        pm = fm + ((wgid % nig) % gsz); pn = (wgid % nig) / gsz; return true;
    }
};
struct SchedPlain {
    TileOrder o; const char* A; const char* B; size_t a_tile, b_tile; int nt;
    __device__ __forceinline__ bool next(int i, Unit& u) const {
        int pm, pn; if (!o.next(i, pm, pn)) return false;
        u.pm = pm; u.pn = pn; u.A = A + (size_t)pm * a_tile; u.B = B + (size_t)pn * b_tile; u.nt = nt; u.kind = 0; return true;
    }
};

template <class Epi, class Sched, bool F16>
__device__ __forceinline__ void gemm_phase(LAS unsigned char* lds, const int lda, const int ldb, const Sched& S, const Epi& E) {
    const int tid = threadIdx.x, wid = __builtin_amdgcn_readfirstlane(tid >> 6), lane = tid & 63, wr = wid >> 2, wc = wid & 3, fr = lane & 15, fq = lane >> 4;
    unsigned voffA[2], voffB[2];
#pragma unroll
    for (int i = 0; i < 2; ++i) { int R, C; stage_rc(tid * 16 + i * 8192, R, C); const int Rb = Epi::PERM ? ((R & ~31) + perm32(R & 31)) : R;
        voffA[i] = (unsigned)(R * lda + C) * 2u; voffB[i] = (unsigned)(Rb * ldb + C) * 2u; }
    const size_t kstep = (size_t)(BK * 2);
    const size_t hstepA = (size_t)HALF * lda * 2, hstepB = (size_t)HALF * ldb * 2;
    const unsigned ldsw = (unsigned)wid * 1024u;
    const int aoff = lds_byte(wr * 64 + fr, fq * 8), boff = lds_byte(wc * 32 + fr, fq * 8);
#define PG8_SA(b, h) (((b) * 2 + (h)) * HTB)
#define PG8_SB(b, h) ((4 + (b) * 2 + (h)) * HTB)
#define PG8_STAGE(bufoff, gbase, voff) do { _Pragma("unroll") for (int _i = 0; _i < 2; ++_i) \
        __builtin_amdgcn_global_load_lds((const unsigned*)((const char*)(gbase) + (voff)[_i]), (LAS unsigned*)(lds + (bufoff) + ldsw + _i * 8192), 16, 0, 0); } while (0)
#define PG8_LDA(dst, b, h) do { _Pragma("unroll") for (int m = 0; m < 4; ++m) _Pragma("unroll") for (int k = 0; k < 2; ++k) dst[m][k] = *(const LAS s16x8*)(lds + PG8_SA(b, h) + aoff + m * 2048 + k * 1024); } while (0)
#define PG8_LDB(dst, b, h) do { _Pragma("unroll") for (int n = 0; n < 2; ++n) _Pragma("unroll") for (int k = 0; k < 2; ++k) dst[n][k] = *(const LAS s16x8*)(lds + PG8_SB(b, h) + boff + n * 2048 + k * 1024); } while (0)
#define PG8_MMA(ai, bj, At, Bt) do { __builtin_amdgcn_s_setprio(1); _Pragma("unroll") for (int m = 0; m < 4; ++m) _Pragma("unroll") for (int n = 0; n < 2; ++n) _Pragma("unroll") for (int k = 0; k < 2; ++k) { \
        if (F16) acc[ai][bj][m][n] = __builtin_amdgcn_mfma_f32_16x16x32_f16(__builtin_bit_cast(h16x8, Bt[n][k]), __builtin_bit_cast(h16x8, At[m][k]), acc[ai][bj][m][n], 0, 0, 0); \
        else acc[ai][bj][m][n] = __builtin_amdgcn_mfma_f32_16x16x32_bf16(Bt[n][k], At[m][k], acc[ai][bj][m][n], 0, 0, 0); } __builtin_amdgcn_s_setprio(0); } while (0)
#define PG8_WAIT_V(n) asm volatile("s_waitcnt vmcnt(" #n ")" ::: "memory")
#define PG8_WAIT_L(n) asm volatile("s_waitcnt lgkmcnt(" #n ")" ::: "memory")
#define PG8_BAR __builtin_amdgcn_s_barrier()
#define PG8_SCHED __builtin_amdgcn_sched_barrier(0)
    Unit cur, nxt; int ui = 0;
    if (!S.next(0, cur)) return;
    f32x4 acc[2][2][4][2];
#pragma unroll
    for (int a = 0; a < 2; ++a)
#pragma unroll
        for (int b = 0; b < 2; ++b)
#pragma unroll
            for (int m = 0; m < 4; ++m)
#pragma unroll
                for (int n = 0; n < 2; ++n) acc[a][b][m][n] = (f32x4){0.f, 0.f, 0.f, 0.f};
    s16x8 At[4][2], B0[2][2], B1[2][2];
    const char* cA = cur.A; const char* cB = cur.B; int nt = cur.nt;
    PG8_STAGE(PG8_SB(0, 0), cB, voffB); PG8_STAGE(PG8_SB(0, 1), cB + hstepB, voffB); PG8_STAGE(PG8_SA(0, 0), cA, voffA); PG8_STAGE(PG8_SA(0, 1), cA + hstepA, voffA);
    if (wr == 1) PG8_BAR;
    PG8_WAIT_V(2); PG8_BAR;
    PG8_STAGE(PG8_SB(1, 0), cB + kstep, voffB); PG8_STAGE(PG8_SA(1, 0), cA + kstep, voffA); PG8_STAGE(PG8_SB(1, 1), cB + hstepB + kstep, voffB);
    PG8_WAIT_V(6); PG8_BAR;
    for (;;) {
        const bool has_next = S.next(ui + 1, nxt);
        const char* nA = has_next ? nxt.A : cA; const char* nB = has_next ? nxt.B : cB;
        for (int t = 0; t < nt; t += 2) {
            const bool last = (t == nt - 2);
            const char* a1 = cA + (size_t)(t + 1) * kstep;
            const char* a2 = last ? nA : cA + (size_t)(t + 2) * kstep; const char* b2 = last ? nB : cB + (size_t)(t + 2) * kstep;
            const char* a3 = a2 + kstep; const char* b3 = b2 + kstep;
            PG8_LDB(B0, 0, 0); PG8_LDB(B1, 0, 1); PG8_SCHED; PG8_LDA(At, 0, 0); PG8_STAGE(PG8_SA(1, 1), a1 + hstepA, voffA);
            PG8_WAIT_V(8); PG8_WAIT_L(0); PG8_BAR; PG8_MMA(0, 0, At, B0); PG8_MMA(0, 1, At, B1); PG8_BAR; PG8_SCHED;
            PG8_LDA(At, 0, 1); PG8_STAGE(PG8_SB(0, 0), b2, voffB); PG8_STAGE(PG8_SB(0, 1), b2 + hstepB, voffB); PG8_STAGE(PG8_SA(0, 0), a2, voffA);
            PG8_WAIT_V(8); PG8_WAIT_L(0); PG8_BAR; PG8_MMA(1, 0, At, B0); PG8_MMA(1, 1, At, B1); PG8_BAR; PG8_SCHED;
            PG8_LDB(B0, 1, 0); PG8_LDB(B1, 1, 1); PG8_SCHED; PG8_LDA(At, 1, 0); PG8_STAGE(PG8_SA(0, 1), a2 + hstepA, voffA);
            PG8_WAIT_V(8); PG8_WAIT_L(0); PG8_BAR; PG8_MMA(0, 0, At, B0); PG8_MMA(0, 1, At, B1); PG8_BAR; PG8_SCHED;
            PG8_LDA(At, 1, 1); PG8_STAGE(PG8_SB(1, 0), b3, voffB); PG8_STAGE(PG8_SB(1, 1), b3 + hstepB, voffB); PG8_STAGE(PG8_SA(1, 0), a3, voffA);
            PG8_WAIT_V(8); PG8_WAIT_L(0); PG8_BAR; PG8_MMA(1, 0, At, B0); PG8_MMA(1, 1, At, B1); PG8_BAR; PG8_SCHED;
        }
        if (wr == 0) PG8_BAR;
        E(acc, cur, wr, wc, fr, fq);
        if (!has_next) break;
#pragma unroll
        for (int a = 0; a < 2; ++a)
#pragma unroll
            for (int b = 0; b < 2; ++b)
#pragma unroll
                for (int m = 0; m < 4; ++m)
#pragma unroll
                    for (int n = 0; n < 2; ++n) acc[a][b][m][n] = (f32x4){0.f, 0.f, 0.f, 0.f};
        cur = nxt; cA = nA; cB = nB; nt = cur.nt; ++ui;
        if (wr == 1) PG8_BAR;
    }
    PG8_WAIT_V(0);
    PG8_BAR;
#undef PG8_SA
#undef PG8_SB
#undef PG8_STAGE
#undef PG8_LDA
#undef PG8_LDB
#undef PG8_MMA
#undef PG8_WAIT_V
#undef PG8_WAIT_L
#undef PG8_BAR
#undef PG8_SCHED
}
}

#define EPI_ROW(u, ai, m) ((u).pm * 256 + (ai) * 128 + wr * 64 + (m) * 16 + fr)
#define EPI_COL8(u, bj) ((u).pn * 256 + (bj) * 128 + wc * 32 + 8 * fq)

struct EpiPP {
    static constexpr bool PERM = true;
    u16* pp;
    __device__ __forceinline__ void operator()(const f32x4 (&acc)[2][2][4][2], const pg8::Unit& u, int wr, int wc, int fr, int fq) const {
#pragma unroll
        for (int ai = 0; ai < 2; ++ai)
#pragma unroll
            for (int m = 0; m < 4; ++m)
#pragma unroll
                for (int bj = 0; bj < 2; ++bj) {
                    const f32x4 v0 = acc[ai][bj][m][0], v1 = acc[ai][bj][m][1];
                    u32x4 w; w.x = cvt_pk_bf16(v0[0], v0[1]); w.y = cvt_pk_bf16(v0[2], v0[3]); w.z = cvt_pk_bf16(v1[0], v1[1]); w.w = cvt_pk_bf16(v1[2], v1[3]);
                    *(u32x4*)(pp + (size_t)EPI_ROW(u, ai, m) * D_ + EPI_COL8(u, bj)) = w;
                }
    }
};
struct EpiPLE {
    static constexpr bool PERM = true;
    float* hres; const u16* pp; const float* rowsq2; float* rowsq3;
    __device__ __forceinline__ void operator()(const f32x4 (&acc)[2][2][4][2], const pg8::Unit& u, int wr, int wc, int fr, int fq) const {
#pragma unroll
        for (int ai = 0; ai < 2; ++ai)
#pragma unroll
            for (int m = 0; m < 4; ++m) {
                const int row = EPI_ROW(u, ai, m);
                const float rstd = rsqrtf(rowsq2[row] * (1.0f / D_) + EPS);
                float ss = 0.f;
#pragma unroll
                for (int bj = 0; bj < 2; ++bj) {
                    const size_t off = (size_t)row * D_ + EPI_COL8(u, bj);
                    const u32x4 pw = *(const u32x4*)(pp + off);
                    const f32x4 h0 = *(const f32x4*)(hres + off), h1 = *(const f32x4*)(hres + off + 4);
                    const f32x4 v0 = acc[ai][bj][m][0], v1 = acc[ai][bj][m][1];
                    f32x4 o0, o1;
                    o0[0] = h0[0] + sigmoidf_(v0[0] * rstd) * bf_lo(pw.x); o0[1] = h0[1] + sigmoidf_(v0[1] * rstd) * bf_hi(pw.x);
                    o0[2] = h0[2] + sigmoidf_(v0[2] * rstd) * bf_lo(pw.y); o0[3] = h0[3] + sigmoidf_(v0[3] * rstd) * bf_hi(pw.y);
                    o1[0] = h1[0] + sigmoidf_(v1[0] * rstd) * bf_lo(pw.z); o1[1] = h1[1] + sigmoidf_(v1[1] * rstd) * bf_hi(pw.z);
                    o1[2] = h1[2] + sigmoidf_(v1[2] * rstd) * bf_lo(pw.w); o1[3] = h1[3] + sigmoidf_(v1[3] * rstd) * bf_hi(pw.w);
                    *(f32x4*)(hres + off) = o0; *(f32x4*)(hres + off + 4) = o1;
                    ss += (o0[0] * o0[0] + o0[1] * o0[1]) + (o0[2] * o0[2] + o0[3] * o0[3]) + (o1[0] * o1[0] + o1[1] * o1[1]) + (o1[2] * o1[2] + o1[3] * o1[3]);
                }
                ss += __shfl_xor(ss, 16); ss += __shfl_xor(ss, 32);
                if (fq == 0) atomicAdd(rowsq3 + row, ss);
            }
    }
};

#define XB_TMO      128
#define XB_XCNT(j)  (256  + 64 * (j))
#define XB_XSUB(j)  (1280 + 64 * (j))
#define XB_XGEN(j)  (2304 + 64 * (j))
#define XB_TOP      3328
#define XB_TOPGEN   3392
#define XCD_BAR_WORDS 3456
#define XB_SPIN_CAP (1u << 18)
__device__ __forceinline__ unsigned xb_ld(unsigned* p)              { return __hip_atomic_load(p, __ATOMIC_RELAXED, __HIP_MEMORY_SCOPE_AGENT); }
__device__ __forceinline__ unsigned xb_add(unsigned* p, unsigned v) { return __hip_atomic_fetch_add(p, v, __ATOMIC_RELAXED, __HIP_MEMORY_SCOPE_AGENT); }
__device__ __forceinline__ unsigned xb_xcc_id() { return (unsigned)__builtin_amdgcn_s_getreg((3 << 11) | 20) & 0xFu; }
#define XB_SPIN(cond, bar) do { unsigned _sp = 0; while (cond) { __builtin_amdgcn_s_sleep(1); \
    if ((++_sp & 255u) == 0u) { if (xb_ld(&(bar)[XB_TMO])) break; if (_sp > XB_SPIN_CAP) { atomicAdd(&(bar)[XB_TMO], 1u); break; } } } } while (0)
struct XcdBarrier { unsigned* bar; unsigned x; volatile LAS unsigned* st; };
__device__ __forceinline__ XcdBarrier xcd_barrier_post(unsigned* bar, volatile LAS unsigned* st) {
    XcdBarrier b; b.bar = bar; b.x = xb_xcc_id(); b.st = st;
    if (threadIdx.x == 0) (void)xb_add(&bar[XB_XCNT(b.x)], 1u);
    return b;
}
__device__ __forceinline__ void xcd_barrier_complete(unsigned* bar, unsigned x, unsigned& nloc, unsigned& nx) {
    const unsigned G = gridDim.x * gridDim.y * gridDim.z;
    unsigned sum, cnt, mine, sp = 0u;
    for (;;) {
        sum = 0u; cnt = 0u; mine = 0u;
#pragma unroll
        for (unsigned j = 0; j < 16; ++j) { const unsigned c = xb_ld(&bar[XB_XCNT(j)]); sum += c; cnt += (c > 0u) ? 1u : 0u; mine = (j == x) ? c : mine; }
        if (sum == G) break;
        __builtin_amdgcn_s_sleep(1);
        if ((++sp & 255u) == 0u) { if (xb_ld(&bar[XB_TMO])) break; if (sp > XB_SPIN_CAP) { atomicAdd(&bar[XB_TMO], 1u); break; } }
    }
    nloc = mine > 0u ? mine : 1u; nx = cnt > 0u ? cnt : 1u;
}
__device__ __forceinline__ void xcd_barrier(const XcdBarrier& b) {
    asm volatile("s_waitcnt vmcnt(0)" ::: "memory");
    __syncthreads();
    if (threadIdx.x == 0) {
        unsigned* bar = b.bar;
        __builtin_amdgcn_s_waitcnt(0);
        unsigned nloc = b.st[0], nx = b.st[1];
        if (nloc == 0u) { xcd_barrier_complete(bar, b.x, nloc, nx); b.st[0] = nloc; b.st[1] = nx; }
        const unsigned old = xb_add(&bar[XB_XSUB(b.x)], 1u);
        const unsigned gen = old / nloc;
        if (old + 1u == (gen + 1u) * nloc) {
            __builtin_amdgcn_fence(__ATOMIC_RELEASE, "agent");
            asm volatile("s_waitcnt vmcnt(0)" ::: "memory");
            const unsigned og = xb_add(&bar[XB_TOP], 1u);
            const unsigned tg = og / nx;
            if (og + 1u == (tg + 1u) * nx) xb_add(&bar[XB_TOPGEN], 1u);
            else XB_SPIN(xb_ld(&bar[XB_TOPGEN]) == tg, bar);
            __builtin_amdgcn_fence(__ATOMIC_ACQUIRE, "agent");
            xb_add(&bar[XB_XGEN(b.x)], 1u);
            asm volatile("s_waitcnt vmcnt(0)" ::: "memory");
        } else {
            XB_SPIN(xb_ld(&bar[XB_XGEN(b.x)]) == gen, bar);
            __builtin_amdgcn_fence(__ATOMIC_ACQUIRE, "agent");
            asm volatile("s_waitcnt vmcnt(0)" ::: "memory");
        }
    }
    __syncthreads();
}

enum { MAP_ID = 0, MAP_WIN = 1, MAP_WGU = 2, MAP_QROPE = 3 };
__device__ __forceinline__ void map_group(int kind, int g, int& src0, int& nv) {
    nv = 32;
    if (kind == MAP_ID) { src0 = 32 * g; }
    else if (kind == MAP_WIN) { const int j0 = 32 * g; if (j0 < 4096) src0 = O_G + j0; else if (j0 < 6144) src0 = O_UV + (j0 - 4096); else { src0 = j0 - 6144; nv = 880 - src0; nv = nv < 0 ? 0 : (nv > 32 ? 32 : nv); } }
    else if (kind == MAP_WGU) { const int tile = g >> 3, sub = g & 7; src0 = (sub < 4) ? tile * 128 + sub * 32 : DFF + tile * 128 + (sub - 4) * 32; }
    else { src0 = g * QHD + NOPE; }
}
template <bool F16>
__device__ __forceinline__ void transpose_item(const float* __restrict__ W, int ldw, int K, u16* Wt, int dst0, int src0, int nv, int k0, const float* __restrict__ gk, LAS float* scr, int lane) {
    const int c = lane & 31;
#pragma unroll 8
    for (int i = 0; i < 32; ++i) { const int kk = 2 * i + (lane >> 5); float v = (c < nv) ? W[(size_t)(k0 + kk) * ldw + src0 + c] : 0.f; if (gk) v *= gk[k0 + kk]; scr[kk * 33 + c] = v; }
    asm volatile("s_waitcnt lgkmcnt(0)" ::: "memory");
    const int c8 = lane & 7;
#pragma unroll
    for (int j = 0; j < 4; ++j) { const int n = (lane >> 3) + 8 * j; const LAS float* s = scr + (8 * c8) * 33 + n;
        u32x4 o;
        if (F16) { o.x = cvt_pk_f16(s[0 * 33], s[1 * 33]); o.y = cvt_pk_f16(s[2 * 33], s[3 * 33]); o.z = cvt_pk_f16(s[4 * 33], s[5 * 33]); o.w = cvt_pk_f16(s[6 * 33], s[7 * 33]); }
        else { o.x = cvt_pk_bf16(s[0 * 33], s[1 * 33]); o.y = cvt_pk_bf16(s[2 * 33], s[3 * 33]); o.z = cvt_pk_bf16(s[4 * 33], s[5 * 33]); o.w = cvt_pk_bf16(s[6 * 33], s[7 * 33]); }
        *(u32x4*)(Wt + (size_t)(dst0 + n) * K + k0 + 8 * c8) = o; }
    asm volatile("s_waitcnt lgkmcnt(0)" ::: "memory");
}
template <bool F16>
__device__ __forceinline__ void transpose_matrix(const float* W, int ldw, int K, u16* Wt, int ngroups, int mapkind, const float* gk, LAS float* scr, int gw, int NGW, int lane) {
    const int nkb = K / 64, nitems = ngroups * nkb;
    for (int it = gw; it < nitems; it += NGW) {
        const int g = it % ngroups, kb = it / ngroups; int src0, nv; map_group(mapkind, g, src0, nv);
        transpose_item<F16>(W, ldw, K, Wt, 32 * g, src0, nv, 64 * kb, gk, scr, lane);
    }
}

typedef short s16x4 __attribute__((ext_vector_type(4)));
__device__ __forceinline__ float wave_sum(float v) {
#pragma unroll
    for (int o = 1; o < 64; o <<= 1) v += __shfl_xor(v, o);
    return v;
}
__device__ __forceinline__ f32x2 gelu_pk(f32x2 v) {
    const f32x2 av = __builtin_elementwise_abs(v), d = av * 0.2316418882f + 1.0f;
    f32x2 t; t.x = __builtin_amdgcn_rcpf(d.x); t.y = __builtin_amdgcn_rcpf(d.y);
    f32x2 q = t * 0.5307027145f + (-0.7265760135f); q = q * t + 0.7107068705f; q = q * t + (-0.142248368f); q = q * t + 0.127414796f; q = q * t;
    const f32x2 s = (v * v) * (-0.72134752044f);
    f32x2 e; e.x = __builtin_amdgcn_exp2f(s.x); e.y = __builtin_amdgcn_exp2f(s.y);
    const f32x2 m = v * (q * e), r = v - m;
    f32x2 o; o.x = v.x < 0.f ? m.x : r.x; o.y = v.y < 0.f ? m.y : r.y; return o;
}

struct EpiIn {
    static constexpr bool PERM = true;
    u16* G; u16* Z; float* RAW; float* rowsqv;
    __device__ __forceinline__ void operator()(const f32x4 (&acc)[2][2][4][2], const pg8::Unit& u, int wr, int wc, int fr, int fq) const {
        const int pn = u.pn;
        if (pn < 16) {
#pragma unroll
            for (int ai = 0; ai < 2; ++ai)
#pragma unroll
                for (int m = 0; m < 4; ++m)
#pragma unroll
                    for (int bj = 0; bj < 2; ++bj) {
                        const f32x4 v0 = acc[ai][bj][m][0], v1 = acc[ai][bj][m][1];
                        u32x4 w; w.x = cvt_pk_bf16(sigmoidf_(v0[0]), sigmoidf_(v0[1])); w.y = cvt_pk_bf16(sigmoidf_(v0[2]), sigmoidf_(v0[3]));
                        w.z = cvt_pk_bf16(sigmoidf_(v1[0]), sigmoidf_(v1[1])); w.w = cvt_pk_bf16(sigmoidf_(v1[2]), sigmoidf_(v1[3]));
                        *(u32x4*)(G + (size_t)EPI_ROW(u, ai, m) * (2 * D_) + EPI_COL8(u, bj)) = w;
                    }
        } else if (pn < 24) {
            const int cb = (pn - 16) * 256;
#pragma unroll
            for (int ai = 0; ai < 2; ++ai)
#pragma unroll
                for (int m = 0; m < 4; ++m) {
                    const int row = EPI_ROW(u, ai, m);
                    float ss = 0.f;
#pragma unroll
                    for (int bj = 0; bj < 2; ++bj) {
                        const f32x4 v0 = acc[ai][bj][m][0], v1 = acc[ai][bj][m][1];
                        const f32x2 a = gelu_pk((f32x2){v0[0], v0[1]}), b = gelu_pk((f32x2){v0[2], v0[3]}), c = gelu_pk((f32x2){v1[0], v1[1]}), d = gelu_pk((f32x2){v1[2], v1[3]});
                        u32x4 w; w.x = cvt_pk_bf16(a.x, a.y); w.y = cvt_pk_bf16(b.x, b.y); w.z = cvt_pk_bf16(c.x, c.y); w.w = cvt_pk_bf16(d.x, d.y);
                        *(u32x4*)(Z + (size_t)row * (2 * SGW) + cb + bj * 128 + wc * 32 + 8 * fq) = w;
                        ss += (a.x * a.x + a.y * a.y) + (b.x * b.x + b.y * b.y) + (c.x * c.x + c.y * c.y) + (d.x * d.x + d.y * d.y);
                    }
                    if (pn >= 20) { ss += __shfl_xor(ss, 16); ss += __shfl_xor(ss, 32); if (fq == 0) atomicAdd(rowsqv + row, ss); }
                }
        } else {
            const int cb = (pn - 24) * 256;
#pragma unroll
            for (int ai = 0; ai < 2; ++ai)
#pragma unroll
                for (int m = 0; m < 4; ++m)
#pragma unroll
                    for (int bj = 0; bj < 2; ++bj) {
                        float* o = RAW + (size_t)EPI_ROW(u, ai, m) * 1024 + cb + bj * 128 + wc * 32 + 8 * fq;
                        *(f32x4*)o = acc[ai][bj][m][0]; *(f32x4*)(o + 4) = acc[ai][bj][m][1];
                    }
        }
    }
};


constexpr float QS = 0.10206207261596575f * 1.4426950408889634f;
struct EpiQ {
    static constexpr bool PERM = false;
    u16* Q; u16* QIDX; const float* ropeT;
    __device__ __forceinline__ void operator()(const f32x4 (&acc)[2][2][4][2], const pg8::Unit& u, int wr, int wc, int fr, int fq) const {
        const int pn = u.pn;
#pragma unroll
        for (int ai = 0; ai < 2; ++ai)
#pragma unroll
            for (int m = 0; m < 4; ++m) {
                const int row = EPI_ROW(u, ai, m), pos = row & (S_ - 1);
                const f32x4 cs = *(const f32x4*)(ropeT + pos * 16 + 4 * fq), sn = *(const f32x4*)(ropeT + S_ * 16 + pos * 16 + 4 * fq);
#pragma unroll
                for (int bj = 0; bj < 2; ++bj) {
                    const f32x4 x1 = acc[ai][bj][m][0], x2 = acc[ai][bj][m][1];
                    if (pn < 2) {
                        const int h = 8 * pn + 4 * bj + wc;
                        const f32x4 o1 = (x1 * cs - x2 * sn) * QS, o2 = (x2 * cs + x1 * sn) * QS;
                        u16* q = Q + ((size_t)row * NH + h) * 288 + 256 + 4 * fq;
                        u32x2 w1, w2; w1.x = cvt_pk_bf16(o1[0], o1[1]); w1.y = cvt_pk_bf16(o1[2], o1[3]); w2.x = cvt_pk_bf16(o2[0], o2[1]); w2.y = cvt_pk_bf16(o2[2], o2[3]);
                        *(u32x2*)q = w1; *(u32x2*)(q + 16) = w2;
                    } else if (pn < 18) {
                        const int h = pn - 2;
                        u16* q = Q + ((size_t)row * NH + h) * 288 + bj * 128 + wc * 32 + 4 * fq;
                        const f32x4 o1 = x1 * QS, o2 = x2 * QS;
                        u32x2 w1, w2; w1.x = cvt_pk_bf16(o1[0], o1[1]); w1.y = cvt_pk_bf16(o1[2], o1[3]); w2.x = cvt_pk_bf16(o2[0], o2[1]); w2.y = cvt_pk_bf16(o2[2], o2[3]);
                        *(u32x2*)q = w1; *(u32x2*)(q + 16) = w2;
                    } else {
                        f32x4 o1 = x1, o2 = x2;
                        if ((wc & 1) == 0) { o1 = x1 * cs - x2 * sn; o2 = x2 * cs + x1 * sn; }
                        u16* q = QIDX + (size_t)row * (IH * IDIM) + (pn - 18) * 256 + bj * 128 + wc * 32 + 4 * fq;
                        u32x2 w1, w2; w1.x = cvt_pk_f16(o1[0], o1[1]); w1.y = cvt_pk_f16(o1[2], o1[3]); w2.x = cvt_pk_f16(o2[0], o2[1]); w2.y = cvt_pk_f16(o2[2], o2[3]);
                        *(u32x2*)q = w1; *(u32x2*)(q + 16) = w2;
                    }
                }
            }
    }
};


struct EpiMerge {
    static constexpr bool PERM = true;
    const u16* G; float* tmp; u16* merged;
    __device__ __forceinline__ void operator()(const f32x4 (&acc)[2][2][4][2], const pg8::Unit& u, int wr, int wc, int fr, int fq) const {
        const int kind = u.kind;
#pragma unroll
        for (int ai = 0; ai < 2; ++ai)
#pragma unroll
            for (int m = 0; m < 4; ++m)
#pragma unroll
                for (int bj = 0; bj < 2; ++bj) {
                    const int row = EPI_ROW(u, ai, m), col = EPI_COL8(u, bj);
                    const size_t off = (size_t)row * D_ + col;
                    const u32x4 gw_ = *(const u32x4*)(G + (size_t)row * (2 * D_) + kind * D_ + col);
                    const f32x4 g0 = (f32x4){bf_lo(gw_.x), bf_hi(gw_.x), bf_lo(gw_.y), bf_hi(gw_.y)}, g1 = (f32x4){bf_lo(gw_.z), bf_hi(gw_.z), bf_lo(gw_.w), bf_hi(gw_.w)};
                    const f32x4 v0 = acc[ai][bj][m][0] * g0, v1 = acc[ai][bj][m][1] * g1;
                    if (kind == 0) { *(f32x4*)(tmp + off) = v0; *(f32x4*)(tmp + off + 4) = v1; }
                    else {
                        const f32x4 t0 = *(const f32x4*)(tmp + off) + v0, t1 = *(const f32x4*)(tmp + off + 4) + v1;
                        u32x4 w; w.x = cvt_pk_bf16(t0[0], t0[1]); w.y = cvt_pk_bf16(t0[2], t0[3]); w.z = cvt_pk_bf16(t1[0], t1[1]); w.w = cvt_pk_bf16(t1[2], t1[3]);
                        *(u32x4*)(merged + off) = w;
                    }
                }
    }
};
struct EpiRes {
    static constexpr bool PERM = true;
    const float* res; float* out; u16* hb; float* rowsq;
    __device__ __forceinline__ void operator()(const f32x4 (&acc)[2][2][4][2], const pg8::Unit& u, int wr, int wc, int fr, int fq) const {
#pragma unroll
        for (int ai = 0; ai < 2; ++ai)
#pragma unroll
            for (int m = 0; m < 4; ++m) {
                const int row = EPI_ROW(u, ai, m);
                float ss = 0.f;
#pragma unroll
                for (int bj = 0; bj < 2; ++bj) {
                    const size_t off = (size_t)row * D_ + EPI_COL8(u, bj);
                    const f32x4 o0 = *(const f32x4*)(res + off) + acc[ai][bj][m][0], o1 = *(const f32x4*)(res + off + 4) + acc[ai][bj][m][1];
                    *(f32x4*)(out + off) = o0; *(f32x4*)(out + off + 4) = o1;
                    u32x4 w; w.x = cvt_pk_bf16(o0[0], o0[1]); w.y = cvt_pk_bf16(o0[2], o0[3]); w.z = cvt_pk_bf16(o1[0], o1[1]); w.w = cvt_pk_bf16(o1[2], o1[3]);
                    *(u32x4*)(hb + off) = w;
                    ss += (o0[0] * o0[0] + o0[1] * o0[1]) + (o0[2] * o0[2] + o0[3] * o0[3]) + (o1[0] * o1[0] + o1[1] * o1[1]) + (o1[2] * o1[2] + o1[3] * o1[3]);
                }
                ss += __shfl_xor(ss, 16); ss += __shfl_xor(ss, 32);
                if (fq == 0) atomicAdd(rowsq + row, ss);
            }
    }
};
struct EpiGU {
    static constexpr bool PERM = true;
    const float* rowsq1; u16* act;
    __device__ __forceinline__ void operator()(const f32x4 (&acc)[2][2][4][2], const pg8::Unit& u, int wr, int wc, int fr, int fq) const {
#pragma unroll
        for (int ai = 0; ai < 2; ++ai)
#pragma unroll
            for (int m = 0; m < 4; ++m) {
                const int row = EPI_ROW(u, ai, m);
                const float rstd = rsqrtf(rowsq1[row] * (1.0f / D_) + EPS);
                f32x4 a[2];
#pragma unroll
                for (int n = 0; n < 2; ++n) {
                    const f32x4 g = acc[ai][0][m][n] * rstd, up = acc[ai][1][m][n] * rstd;
#pragma unroll
                    for (int e = 0; e < 4; ++e) a[n][e] = g[e] * sigmoidf_(g[e]) * up[e];
                }
                u32x4 w; w.x = cvt_pk_bf16(a[0][0], a[0][1]); w.y = cvt_pk_bf16(a[0][2], a[0][3]); w.z = cvt_pk_bf16(a[1][0], a[1][1]); w.w = cvt_pk_bf16(a[1][2], a[1][3]);
                *(u32x4*)(act + (size_t)row * DFF + u.pn * 128 + wc * 32 + 8 * fq) = w;
            }
    }
};
struct SchedPair {
    pg8::TileOrder o; const char *A0, *B0, *A1, *B1; size_t a_tile, b_tile; int nt;
    __device__ __forceinline__ bool next(int i, pg8::Unit& u) const {
        int pm, pn; if (!o.next(i >> 1, pm, pn)) return false;
        const int kind = i & 1;
        u.pm = pm; u.pn = pn; u.A = (kind ? A1 : A0) + (size_t)pm * a_tile; u.B = (kind ? B1 : B0) + (size_t)pn * b_tile; u.nt = nt; u.kind = kind; return true;
    }
};

constexpr int NWAVES = 8;
constexpr int RING_BYTES = 131072, MISC_OFF = RING_BYTES + 320, LDS_BYTES = 147456;
struct Args { const float* in[23]; float* out; unsigned char* ws; unsigned mask; unsigned pad; };
constexpr int NQ_ROWS = 512 + 4096 + 1024;

__global__ void __launch_bounds__(NWAVES * 64, 2) mega(Args args) {
    extern __shared__ __attribute__((aligned(16))) unsigned char lds_raw[];
    LAS unsigned char* lds = (LAS unsigned char*)lds_raw;
    volatile LAS unsigned* MISC = (volatile LAS unsigned*)(lds + MISC_OFF);
    const int tid = threadIdx.x, lane = tid & 63, wave = __builtin_amdgcn_readfirstlane(tid >> 6);
    const int G = gridDim.x, bx = blockIdx.x;
    const int vcu = (G % 8 == 0) ? (bx % 8) * (G / 8) + bx / 8 : bx;
    const int gw = vcu * NWAVES + wave, NGW = G * NWAVES;
    unsigned char* ws = args.ws;
    for (int u = tid; u < (LDS_BYTES - RING_BYTES) / 4; u += NWAVES * 64) ((LAS unsigned*)(lds + RING_BYTES))[u] = 0u;
    __syncthreads();
    const XcdBarrier bar = xcd_barrier_post((unsigned*)(ws + WS_CTL), MISC + 8);
    const unsigned mask = args.mask;
    LAS float* scr = (LAS float*)(lds + wave * 16384);
    u16* WIN = (u16*)(ws + WS_WIN); u16* WQ = (u16*)(ws + WS_WQ); u16* WA = (u16*)(ws + WS_WA); u16* WB = (u16*)(ws + WS_WB); u16* WO = (u16*)(ws + WS_WO);
    u16* N16 = (u16*)(ws + WS_N16); u16* P16 = (u16*)(ws + WS_P16);
    float* ropeT = (float*)(ws + WS_ROPE); float* rowsqv = (float*)(ws + WS_RSQV);
    u16* Gb = (u16*)args.out; u16* Zb = (u16*)(ws + WS_Z); float* RAW = (float*)(ws + WS_RAW);

    if (mask & (1u << 0)) {
        transpose_matrix<true>(args.in[3], INC, D_, WIN, 7168 / 32, MAP_WIN, nullptr, scr, gw, NGW, lane);
        transpose_matrix<true>(args.in[6], NH * QHD, QLORA, WQ, 512 / 32, MAP_QROPE, nullptr, scr, gw, NGW, lane);
        transpose_matrix<true>(args.in[9], IH * IDIM, QLORA, WQ + (size_t)4608 * QLORA, 1024 / 32, MAP_ID, nullptr, scr, gw, NGW, lane);
        transpose_matrix<false>(args.in[10], D_, ATTW, WA, D_ / 32, MAP_ID, nullptr, scr, gw, NGW, lane);
        transpose_matrix<false>(args.in[14], D_, SGW, WB, D_ / 32, MAP_ID, nullptr, scr, gw, NGW, lane);
        transpose_matrix<false>(args.in[15], D_, D_, WO, D_ / 32, MAP_ID, nullptr, scr, gw, NGW, lane);
        transpose_matrix<false>(args.in[8], ATTW, KVL, (u16*)(ws + WS_WUV), ATTW / 32, MAP_ID, nullptr, scr, gw, NGW, lane);
        {
            const float* w_uq = args.in[6]; const float* w_uk = args.in[7];
            for (int it = gw; it < NH * 8 * 16; it += NGW) {
                const int h = it >> 7, kb = (it >> 4) & 7, cg = it & 15, k = kb * 64 + lane;
                f32x4 a[16];
#pragma unroll
                for (int i = 0; i < 16; ++i) a[i] = *(const f32x4*)(w_uq + (size_t)k * (NH * QHD) + h * QHD + 4 * i);
                for (int cc = 0; cc < 16; ++cc) {
                    const int c = cg * 16 + cc;
                    const float* wk = w_uk + ((size_t)c * NH + h) * NOPE;
                    float s = 0.f;
#pragma unroll
                    for (int i = 0; i < 16; ++i) { const f32x4 b = *(const f32x4*)(wk + 4 * i); s += (a[i][0] * b[0] + a[i][1] * b[1]) + (a[i][2] * b[2] + a[i][3] * b[3]); }
                    const _Float16 hv = (_Float16)s;
                    WQ[(size_t)(512 + h * 256 + c) * QLORA + k] = __builtin_bit_cast(unsigned short, hv);
                }
            }
        }
        {
            const float* x = args.in[0]; const float* g = args.in[2];
            for (int m = gw; m < T_; m += NGW) {
                const float* xr = x + (size_t)m * D_;
                f32x4 v[8]; float s = 0.f;
#pragma unroll
                for (int j = 0; j < 8; ++j) { v[j] = *(const f32x4*)(xr + 4 * lane + 256 * j); s += (v[j][0] * v[j][0] + v[j][1] * v[j][1]) + (v[j][2] * v[j][2] + v[j][3] * v[j][3]); }
                const float rstd = rsqrtf(wave_sum(s) * (1.0f / D_) + EPS);
#pragma unroll
                for (int j = 0; j < 8; ++j) { const f32x4 gg = *(const f32x4*)(g + 4 * lane + 256 * j); const f32x4 o = v[j] * rstd * gg;
                    u32x2 w; w.x = cvt_pk_f16(o[0], o[1]); w.y = cvt_pk_f16(o[2], o[3]); *(u32x2*)(N16 + (size_t)m * D_ + 4 * lane + 256 * j) = w; }
            }
        }
        {
            const float* p = args.in[1];
            for (size_t i = (size_t)(gw * 64 + lane) * 8; i < (size_t)T_ * PLE; i += (size_t)NGW * 64 * 8) {
                const f32x4 a = *(const f32x4*)(p + i), b = *(const f32x4*)(p + i + 4);
                u32x4 w; w.x = cvt_pk_bf16(a[0], a[1]); w.y = cvt_pk_bf16(a[2], a[3]); w.z = cvt_pk_bf16(b[0], b[1]); w.w = cvt_pk_bf16(b[2], b[3]);
                *(u32x4*)(P16 + i) = w;
            }
        }
        for (int i = gw * 64 + lane; i < S_ * 16; i += NGW * 64) { const int j = i & 15, pos = i >> 4; const float inv = powf(10000.0f, -(float)(2 * j) / 32.0f); const float ang = (float)pos * inv;
            ropeT[i] = cosf(ang); ropeT[S_ * 16 + i] = sinf(ang); }
        for (int i = gw * 64 + lane; i < 4 * T_; i += NGW * 64) rowsqv[i] = 0.f;
        xcd_barrier(bar);
    }
    if (mask & (1u << 1)) {
        pg8::SchedPlain S; S.o.init(T_ / 256, 7168 / 256, G, bx); S.A = (const char*)N16; S.B = (const char*)WIN; S.a_tile = (size_t)256 * D_ * 2; S.b_tile = (size_t)256 * D_ * 2; S.nt = D_ / 64;
        EpiIn E{Gb, Zb, RAW, rowsqv};
        pg8::gemm_phase<EpiIn, pg8::SchedPlain, true>(lds, D_, D_, S, E);
        xcd_barrier(bar);
    }
    u16* CQ = (u16*)(ws + WS_CQ); u16* KV = (u16*)(ws + WS_KV); u16* KIDX = (u16*)(ws + WS_KIDX); float* WIDX = (float*)(ws + WS_WIDX);
    u16* Qb = (u16*)(ws + WS_Q); u16* QIDX = (u16*)(ws + WS_QIDX);
    if (mask & (1u << 2)) {
        const float* g_cq = args.in[4]; const float* g_ckv = args.in[5];
        for (int m = gw; m < T_; m += NGW) {
            const float* r = RAW + (size_t)m * 1024; const int pos = m & (S_ - 1);
            const f32x4 a0 = *(const f32x4*)(r + 4 * lane), a1 = *(const f32x4*)(r + 256 + 4 * lane), cv = *(const f32x4*)(r + 512 + 4 * lane);
            const float s1 = (a0[0] * a0[0] + a0[1] * a0[1]) + (a0[2] * a0[2] + a0[3] * a0[3]) + (a1[0] * a1[0] + a1[1] * a1[1]) + (a1[2] * a1[2] + a1[3] * a1[3]);
            const float s2 = (cv[0] * cv[0] + cv[1] * cv[1]) + (cv[2] * cv[2] + cv[3] * cv[3]);
            const float r1 = rsqrtf(wave_sum(s1) * (1.0f / QLORA) + EPS), r2 = rsqrtf(wave_sum(s2) * (1.0f / KVL) + EPS);
            const f32x4 g0 = *(const f32x4*)(g_cq + 4 * lane), g1 = *(const f32x4*)(g_cq + 256 + 4 * lane), gk = *(const f32x4*)(g_ckv + 4 * lane);
            const f32x4 o0 = a0 * r1 * g0, o1 = a1 * r1 * g1, ok = cv * r2 * gk;
            u32x2 w; w.x = cvt_pk_f16(o0[0], o0[1]); w.y = cvt_pk_f16(o0[2], o0[3]); *(u32x2*)(CQ + (size_t)m * QLORA + 4 * lane) = w;
            w.x = cvt_pk_f16(o1[0], o1[1]); w.y = cvt_pk_f16(o1[2], o1[3]); *(u32x2*)(CQ + (size_t)m * QLORA + 256 + 4 * lane) = w;
            w.x = cvt_pk_bf16(ok[0], ok[1]); w.y = cvt_pk_bf16(ok[2], ok[3]); *(u32x2*)(KV + (size_t)m * 288 + 4 * lane) = w;
            if (lane < 16) {
                const float c = ropeT[pos * 16 + lane], sn = ropeT[S_ * 16 + pos * 16 + lane];
                const float x1 = r[768 + lane], x2 = r[784 + lane];
                KV[(size_t)m * 288 + 256 + lane] = (u16)(cvt_pk_bf16(x1 * c - x2 * sn, 0.f) & 0xffffu);
                KV[(size_t)m * 288 + 272 + lane] = (u16)(cvt_pk_bf16(x2 * c + x1 * sn, 0.f) & 0xffffu);
                WIDX[(size_t)m * IH + lane] = r[864 + lane] * (1.0f / 32.0f);
            } else if (lane < 32) {
                const int j = lane - 16;
                const float c = ropeT[pos * 16 + j], sn = ropeT[S_ * 16 + pos * 16 + j];
                const float x1 = r[800 + j], x2 = r[816 + j];
                KIDX[(size_t)m * IDIM + j] = (u16)(cvt_pk_f16(x1 * c - x2 * sn, 0.f) & 0xffffu);
                KIDX[(size_t)m * IDIM + 16 + j] = (u16)(cvt_pk_f16(x2 * c + x1 * sn, 0.f) & 0xffffu);
            } else {
                KIDX[(size_t)m * IDIM + lane] = (u16)(cvt_pk_f16(r[800 + lane], 0.f) & 0xffffu);
            }
        }
        xcd_barrier(bar);
    }
    if (mask & (1u << 3)) {
        pg8::SchedPlain S; S.o.init(T_ / 256, NQ_ROWS / 256, G, bx); S.A = (const char*)CQ; S.B = (const char*)WQ; S.a_tile = (size_t)256 * QLORA * 2; S.b_tile = (size_t)256 * QLORA * 2; S.nt = QLORA / 64;
        EpiQ E{Qb, QIDX, ropeT};
        pg8::gemm_phase<EpiQ, pg8::SchedPlain, true>(lds, QLORA, QLORA, S, E);
        xcd_barrier(bar);
    }
    u16* SEL = (u16*)(ws + WS_SEL); u16* Sb = (u16*)(ws + WS_S);
    if (mask & (1u << 4)) {
        {
            LAS float* sc = (LAS float*)(lds + wave * 8192);
            const int g4 = lane >> 4, c16 = lane & 15;
            for (int q = gw; q < T_; q += NGW) {
                const int b = q >> 11, pp = q & (S_ - 1), s = (b & 1) ? (S_ - 1 - pp) : pp;
                const int t = b * S_ + s, n = s + 1;
                if (n <= TOPK) { for (int j = lane; j < n; j += 64) SEL[(size_t)t * TOPK + j] = (u16)j; continue; }
                const u16* qa = QIDX + (size_t)t * (IH * IDIM) + c16 * IDIM + g4 * 8;
                const h16x8 af0 = *(const h16x8*)qa, af1 = *(const h16x8*)(qa + 32);
                const f32x4 w4 = *(const f32x4*)(WIDX + (size_t)t * IH + 4 * g4);
                const int ntile = (n + 15) >> 4;
                const u16* kb = KIDX + ((size_t)b * S_ + c16) * IDIM + g4 * 8;
#pragma unroll 4
                for (int tile = 0; tile < ntile; ++tile) {
                    const h16x8 b0 = *(const h16x8*)(kb + (size_t)tile * 16 * IDIM), b1 = *(const h16x8*)(kb + (size_t)tile * 16 * IDIM + 32);
                    f32x4 acc = (f32x4){0.f, 0.f, 0.f, 0.f};
                    acc = __builtin_amdgcn_mfma_f32_16x16x32_f16(af0, b0, acc, 0, 0, 0);
                    acc = __builtin_amdgcn_mfma_f32_16x16x32_f16(af1, b1, acc, 0, 0, 0);
                    float v = fmaxf(acc[0], 0.f) * w4[0] + fmaxf(acc[1], 0.f) * w4[1] + fmaxf(acc[2], 0.f) * w4[2] + fmaxf(acc[3], 0.f) * w4[3];
                    v += __shfl_xor(v, 16); v += __shfl_xor(v, 32);
                    if (g4 == 0) sc[tile * 16 + c16] = v;
                }
                unsigned u[32];
#pragma unroll
                for (int i = 0; i < 32; ++i) { const int idx = i * 64 + lane; const unsigned bits = __float_as_uint(sc[idx]); const unsigned key = (bits & 0x80000000u) ? ~bits : (bits | 0x80000000u); u[i] = (idx < n) ? key : 0u; }
                unsigned prefix = 0u;
                for (int bit = 31; bit >= 0; --bit) {
                    const unsigned cand = prefix | (1u << bit);
                    int cnt = 0;
#pragma unroll
                    for (int i = 0; i < 32; ++i) cnt += __popcll(__ballot(u[i] >= cand));
                    if (cnt >= TOPK) prefix = cand;
                }
                int cgt = 0;
#pragma unroll
                for (int i = 0; i < 32; ++i) cgt += __popcll(__ballot(u[i] > prefix));
                const int need_eq = TOPK - cgt;
                const unsigned long long ltmask = (1ull << lane) - 1ull;
                int bgt = 0, beq = 0;
                u16* so = SEL + (size_t)t * TOPK;
#pragma unroll
                for (int i = 0; i < 32; ++i) {
                    const unsigned long long mg = __ballot(u[i] > prefix), me = __ballot(u[i] == prefix);
                    if (u[i] > prefix) so[bgt + __popcll(mg & ltmask)] = (u16)(i * 64 + lane);
                    else if (u[i] == prefix) { const int rk = beq + __popcll(me & ltmask); if (rk < need_eq) so[cgt + rk] = (u16)(i * 64 + lane); }
                    bgt += __popcll(mg); beq += __popcll(me);
                }
            }
        }
        {
            LAS float* zt = (LAS float*)lds; LAS float* wt = (LAS float*)(lds + 65536);
            const float* w_sp = args.in[12]; const float* b_sp = args.in[13]; const float* g_sgu = args.in[11];
            __syncthreads();
            for (int it = vcu; it < 512; it += G) {
                const int gi = it & 7, t0 = (it >> 3) * CH;
                for (int e = tid; e < CH * 16; e += NWAVES * 64) {
                    const int ss = e >> 4, c8 = (e & 15) * 8;
                    const u32x4 zw = *(const u32x4*)(Zb + (size_t)(t0 + ss) * (2 * SGW) + SGW + gi * 128 + c8);
                    LAS float* d = zt + ss * 128 + c8;
                    d[0] = bf_lo(zw.x); d[1] = bf_hi(zw.x); d[2] = bf_lo(zw.y); d[3] = bf_hi(zw.y); d[4] = bf_lo(zw.z); d[5] = bf_hi(zw.z); d[6] = bf_lo(zw.w); d[7] = bf_hi(zw.w);
                }
                for (int e = tid; e < CH * 32; e += NWAVES * 64) {
                    const int tt = e >> 5, s4 = (e & 31) * 4;
                    f32x4 w = *(const f32x4*)(w_sp + ((size_t)gi * CH + tt) * CH + s4);
                    const f32x4 rq = *(const f32x4*)(rowsqv + t0 + s4);
                    w[0] *= rsqrtf(rq[0] * (1.0f / SGW) + EPS); w[1] *= rsqrtf(rq[1] * (1.0f / SGW) + EPS); w[2] *= rsqrtf(rq[2] * (1.0f / SGW) + EPS); w[3] *= rsqrtf(rq[3] * (1.0f / SGW) + EPS);
                    *(LAS f32x4*)(wt + tt * 128 + s4) = w;
                }
                __syncthreads();
                {
                    const int c = tid & 127, tq = tid >> 7;
                    const float gs = g_sgu[gi * 128 + c];
                    for (int j = 0; j < 32; ++j) {
                        const int tt = tq + 4 * j;
                        float a = 0.f;
                        for (int ss = 0; ss <= tt; ++ss) a = fmaf(wt[tt * 128 + ss], zt[ss * 128 + c], a);
                        const float mixed = gs * a + b_sp[gi * CH + tt];
                        const size_t row = (size_t)(t0 + tt);
                        const float uu = __uint_as_float((unsigned)Zb[row * (2 * SGW) + gi * 128 + c] << 16);
                        Sb[row * SGW + gi * 128 + c] = (u16)(cvt_pk_bf16(uu * mixed, 0.f) & 0xffffu);
                    }
                }
                __syncthreads();
            }
        }
        xcd_barrier(bar);
    }
    u16* OLAT = (u16*)(ws + WS_OLAT); u16* OA = (u16*)(ws + WS_OA); u16* WUVT = (u16*)(ws + WS_WUV);
    if (mask & (1u << 5)) {
        {
            LAS unsigned char* wl = lds + wave * 16384;
            const int g4 = lane >> 4, c16 = lane & 15, q4 = c16 >> 2, p4 = lane & 3;
            const int kap0 = 4 * g4 + q4;
            const int fk = ((kap0 & 7) << 1) | ((kap0 >> 3) & 1);
            const unsigned trbase = (unsigned)kap0 * 512u + 8u * (p4 & 1);
            for (int q = gw; q < T_; q += NGW) {
                int t = q; if (NGW == 2048) t = (gw >> 9) * S_ + (gw & 511) + 512 * (q >> 11);
                const int b = t >> 11, spos = t & (S_ - 1), n = (spos + 1 < TOPK) ? spos + 1 : TOPK, nch = (n + 31) >> 5;
                s16x8 bq[9];
#pragma unroll
                for (int ks = 0; ks < 9; ++ks) bq[ks] = *(const s16x8*)(Qb + ((size_t)t * NH + c16) * 288 + ks * 32 + g4 * 8);
                f32x4 o[16];
#pragma unroll
                for (int ct = 0; ct < 16; ++ct) o[ct] = (f32x4){0.f, 0.f, 0.f, 0.f};
                float mrun = -INFINITY, lrun = 0.f;
                const u16* selr = SEL + (size_t)t * TOPK;
                const u16* kvb = KV + (size_t)b * S_ * 288;
                for (int kc = 0; kc < nch; ++kc) {
#pragma unroll
                    for (int i = 0; i < 16; ++i) {
                        const int e = i * 64 + lane, key = e >> 5, ch = e & 31, slot = kc * 32 + key;
                        const int kid = (slot < n) ? (int)selr[slot] : 0;
                        const u32x4 v = *(const u32x4*)(kvb + (size_t)kid * 288 + ch * 8);
                        const int fkey = ((key & 7) << 1) | ((key >> 3) & 1);
                        *(LAS u32x4*)(wl + key * 512 + ((ch ^ fkey) << 4)) = v;
                    }
                    f32x4 st[2];
#pragma unroll
                    for (int tile = 0; tile < 2; ++tile) {
                        const int key = tile * 16 + c16, slot = kc * 32 + key;
                        const int kid = (slot < n) ? (int)selr[slot] : 0;
                        const s16x8 ar = *(const s16x8*)(kvb + (size_t)kid * 288 + 256 + g4 * 8);
                        const int fkey = ((key & 7) << 1) | ((key >> 3) & 1);
                        f32x4 acc = (f32x4){0.f, 0.f, 0.f, 0.f};
#pragma unroll
                        for (int ks = 0; ks < 8; ++ks) {
                            const s16x8 a = *(const LAS s16x8*)(wl + key * 512 + (((ks * 4 + g4) ^ fkey) << 4));
                            acc = __builtin_amdgcn_mfma_f32_16x16x32_bf16(a, bq[ks], acc, 0, 0, 0);
                        }
                        acc = __builtin_amdgcn_mfma_f32_16x16x32_bf16(ar, bq[8], acc, 0, 0, 0);
#pragma unroll
                        for (int r = 0; r < 4; ++r) if (kc * 32 + tile * 16 + 4 * g4 + r >= n) acc[r] = -INFINITY;
                        st[tile] = acc;
                    }
                    float cm = fmaxf(fmaxf(fmaxf(st[0][0], st[0][1]), fmaxf(st[0][2], st[0][3])), fmaxf(fmaxf(st[1][0], st[1][1]), fmaxf(st[1][2], st[1][3])));
                    cm = fmaxf(cm, __shfl_xor(cm, 16)); cm = fmaxf(cm, __shfl_xor(cm, 32));
                    const float mn = fmaxf(mrun, cm);
                    const float sco = __builtin_amdgcn_exp2f(mrun - mn);
                    mrun = mn;
                    f32x4 p0, p1;
#pragma unroll
                    for (int r = 0; r < 4; ++r) { p0[r] = __builtin_amdgcn_exp2f(st[0][r] - mn); p1[r] = __builtin_amdgcn_exp2f(st[1][r] - mn); }
                    lrun = lrun * sco + ((p0[0] + p0[1]) + (p0[2] + p0[3])) + ((p1[0] + p1[1]) + (p1[2] + p1[3]));
                    u32x4 pw; pw.x = cvt_pk_bf16(p0[0], p0[1]); pw.y = cvt_pk_bf16(p0[2], p0[3]); pw.z = cvt_pk_bf16(p1[0], p1[1]); pw.w = cvt_pk_bf16(p1[2], p1[3]);
                    const s16x8 pf = __builtin_bit_cast(s16x8, pw);
#pragma unroll
                    for (int ct = 0; ct < 16; ++ct) {
                        const unsigned a0 = trbase + ((unsigned)((ct * 2 + (p4 >> 1)) ^ fk) << 4);
                        const s16x4 lo = __builtin_amdgcn_ds_read_tr16_b64_v4i16((LAS s16x4*)(wl + a0));
                        const s16x4 hi = __builtin_amdgcn_ds_read_tr16_b64_v4i16((LAS s16x4*)(wl + a0 + 8192));
                        const s16x8 av = __builtin_shufflevector(lo, hi, 0, 1, 2, 3, 4, 5, 6, 7);
                        o[ct] = o[ct] * sco;
                        o[ct] = __builtin_amdgcn_mfma_f32_16x16x32_bf16(av, pf, o[ct], 0, 0, 0);
                    }
                }
                float lt = lrun; lt += __shfl_xor(lt, 16); lt += __shfl_xor(lt, 32);
                const float inv = 1.0f / lt;
                u16* orow = OLAT + ((size_t)t * NH + c16) * KVL + 4 * g4;
#pragma unroll
                for (int ct = 0; ct < 16; ++ct) { const f32x4 v = o[ct] * inv; u32x2 w; w.x = cvt_pk_bf16(v[0], v[1]); w.y = cvt_pk_bf16(v[2], v[3]); *(u32x2*)(orow + ct * 16) = w; }
            }
        }
        xcd_barrier(bar);
        {
            const int g4 = lane >> 4, c16 = lane & 15;
            for (int it = gw; it < (T_ / 16) * NH; it += NGW) {
                const int tg = it >> 4, h = it & 15;
                s16x8 bo[8];
#pragma unroll
                for (int ks = 0; ks < 8; ++ks) bo[ks] = *(const s16x8*)(OLAT + ((size_t)(tg * 16 + c16) * NH + h) * KVL + ks * 32 + g4 * 8);
#pragma unroll
                for (int nt = 0; nt < 4; ++nt) {
                    f32x4 acc = (f32x4){0.f, 0.f, 0.f, 0.f};
#pragma unroll
                    for (int ks = 0; ks < 8; ++ks) {
                        const s16x8 a = *(const s16x8*)(WUVT + (size_t)(h * 64 + nt * 16 + c16) * KVL + ks * 32 + g4 * 8);
                        acc = __builtin_amdgcn_mfma_f32_16x16x32_bf16(a, bo[ks], acc, 0, 0, 0);
                    }
                    u32x2 w; w.x = cvt_pk_bf16(acc[0], acc[1]); w.y = cvt_pk_bf16(acc[2], acc[3]);
                    *(u32x2*)(OA + (size_t)(tg * 16 + c16) * ATTW + h * 64 + nt * 16 + 4 * g4) = w;
                }
            }
        }
        xcd_barrier(bar);
    }
    float* rowsq1 = rowsqv + T_; float* rowsq2 = rowsqv + 2 * T_; float* rowsq3 = rowsqv + 3 * T_;
    float* TMP = (float*)(ws + WS_TMP); u16* MERGED = (u16*)(ws + WS_MERGED); u16* H1B = (u16*)(ws + WS_H1B); u16* ACT = (u16*)(ws + WS_ACT);
    u16* H2B = (u16*)(ws + WS_H2B); u16* PP = (u16*)(ws + WS_PP);
    u16* WGU = (u16*)(ws + WS_WGU); u16* WDN = (u16*)(ws + WS_WDN); u16* WPG = (u16*)(ws + WS_WPG); u16* WPP = (u16*)(ws + WS_WPP);
    if (mask & (1u << 6)) {
        SchedPair S; S.o.init(T_ / 256, D_ / 256, G, bx); S.A0 = (const char*)OA; S.B0 = (const char*)WA; S.A1 = (const char*)Sb; S.B1 = (const char*)WB;
        S.a_tile = (size_t)256 * ATTW * 2; S.b_tile = (size_t)256 * ATTW * 2; S.nt = ATTW / 64;
        EpiMerge E{Gb, TMP, MERGED};
        pg8::gemm_phase<EpiMerge, SchedPair, false>(lds, ATTW, ATTW, S, E);
        xcd_barrier(bar);
    }
    if (mask & (1u << 7)) {
        transpose_matrix<false>(args.in[17], 2 * DFF, D_, WGU, 2 * DFF / 32, MAP_WGU, args.in[16], scr, gw, NGW, lane);
        transpose_matrix<false>(args.in[18], D_, DFF, WDN, D_ / 32, MAP_ID, nullptr, scr, gw, NGW, lane);
        transpose_matrix<false>(args.in[20], D_, D_, WPG, D_ / 32, MAP_ID, args.in[19], scr, gw, NGW, lane);
        transpose_matrix<false>(args.in[21], D_, PLE, WPP, D_ / 32, MAP_ID, nullptr, scr, gw, NGW, lane);
        __syncthreads();
        pg8::SchedPlain S; S.o.init(T_ / 256, D_ / 256, G, bx); S.A = (const char*)MERGED; S.B = (const char*)WO; S.a_tile = (size_t)256 * D_ * 2; S.b_tile = (size_t)256 * D_ * 2; S.nt = D_ / 64;
        EpiRes E{args.in[0], args.out, H1B, rowsq1};
        pg8::gemm_phase<EpiRes, pg8::SchedPlain, false>(lds, D_, D_, S, E);
        xcd_barrier(bar);
    }
    if (mask & (1u << 8)) {
        pg8::SchedPlain S; S.o.init(T_ / 256, 2 * DFF / 256, G, bx); S.A = (const char*)H1B; S.B = (const char*)WGU; S.a_tile = (size_t)256 * D_ * 2; S.b_tile = (size_t)256 * D_ * 2; S.nt = D_ / 64;
        EpiGU E{rowsq1, ACT};
        pg8::gemm_phase<EpiGU, pg8::SchedPlain, false>(lds, D_, D_, S, E);
        xcd_barrier(bar);
    }
    if (mask & (1u << 9)) {
        pg8::SchedPlain S; S.o.init(T_ / 256, D_ / 256, G, bx); S.A = (const char*)ACT; S.B = (const char*)WDN; S.a_tile = (size_t)256 * DFF * 2; S.b_tile = (size_t)256 * DFF * 2; S.nt = DFF / 64;
        EpiRes E{args.out, args.out, H2B, rowsq2};
        pg8::gemm_phase<EpiRes, pg8::SchedPlain, false>(lds, DFF, DFF, S, E);
        xcd_barrier(bar);
    }
    if (mask & (1u << 10)) {
        {
            pg8::SchedPlain S; S.o.init(T_ / 256, D_ / 256, G, bx); S.A = (const char*)P16; S.B = (const char*)WPP; S.a_tile = (size_t)256 * PLE * 2; S.b_tile = (size_t)256 * PLE * 2; S.nt = PLE / 64;
            EpiPP E{PP};
            pg8::gemm_phase<EpiPP, pg8::SchedPlain, false>(lds, PLE, PLE, S, E);
        }
        {
            pg8::SchedPlain S; S.o.init(T_ / 256, D_ / 256, G, bx); S.A = (const char*)H2B; S.B = (const char*)WPG; S.a_tile = (size_t)256 * D_ * 2; S.b_tile = (size_t)256 * D_ * 2; S.nt = D_ / 64;
            EpiPLE E{args.out, PP, rowsq2, rowsq3};
            pg8::gemm_phase<EpiPLE, pg8::SchedPlain, false>(lds, D_, D_, S, E);
        }
        xcd_barrier(bar);
    }
    if (mask & (1u << 11)) {
        const float* gf = args.in[22];
        for (int m = gw; m < T_; m += NGW) {
            float* row = args.out + (size_t)m * D_;
            const float rstd = rsqrtf(rowsq3[m] * (1.0f / D_) + EPS);
#pragma unroll
            for (int j = 0; j < 8; ++j) { const int c = 4 * lane + 256 * j; f32x4 v = *(const f32x4*)(row + c); const f32x4 g = *(const f32x4*)(gf + c); v = v * rstd * g; *(f32x4*)(row + c) = v; }
        }
    }
}

__global__ void __launch_bounds__(256) qlat_k(const float* __restrict__ q, const float* __restrict__ w_uk, float* __restrict__ ql) {
    const int row = blockIdx.x;
    for (int i = threadIdx.x; i < NH * KVL; i += 256) {
        const int h = i / KVL, c = i % KVL;
        const float* w = w_uk + ((size_t)c * NH + h) * NOPE; const float* qq = q + (size_t)row * (NH * QHD) + h * QHD;
        float a = 0.f;
        for (int k = 0; k < NOPE; ++k) a = fmaf(qq[k], w[k], a);
        ql[(size_t)row * (NH * KVL) + i] = a;
    }
}
__global__ void __launch_bounds__(256) selcmp_k(const u16* __restrict__ nw, const int* __restrict__ orc, unsigned* res, int idx) {
    __shared__ int miss;
    if (threadIdx.x == 0) miss = 0;
    __syncthreads();
    const int key = orc[(size_t)blockIdx.x * TOPK + threadIdx.x];
    bool found = false;
    for (int j = 0; j < TOPK; ++j) found |= ((int)nw[(size_t)blockIdx.x * TOPK + j] == key);
    if (!found) atomicAdd(&miss, 1);
    __syncthreads();
    if (threadIdx.x == 0) { atomicMax(res + 2 * idx, __float_as_uint((float)miss / (float)TOPK)); atomicMax(res + 2 * idx + 1, __float_as_uint(1.0f)); }
}
__global__ void sel2int_k(const u16* __restrict__ nw, int* __restrict__ sel, int* __restrict__ cnt, int rows) {
    const int i = blockIdx.x * blockDim.x + threadIdx.x;
    if (i < rows * TOPK) sel[i] = nw[i];
    if (i < rows) cnt[i] = TOPK;
}
template <int TY  >
__global__ void __launch_bounds__(256) cmp_k(const void* nw, size_t ldn, const float* __restrict__ orc, size_t ldo, int cols, int xform, float scale, unsigned* res, int idx, size_t cso = 1) {
    __shared__ float red[8];
    float md = 0.f, mr = 0.f;
    for (int c = threadIdx.x; c < cols; c += 256) {
        float a;
        if (TY == 0) a = ((const float*)nw)[blockIdx.x * ldn + c];
        else if (TY == 1) a = __uint_as_float((unsigned)((const u16*)nw)[blockIdx.x * ldn + c] << 16);
        else a = (float)__builtin_bit_cast(_Float16, ((const u16*)nw)[blockIdx.x * ldn + c]);
        float b = orc[blockIdx.x * ldo + c * cso];
        if (xform == 1) b = 1.0f / (1.0f + expf(-b));
        b *= scale;
        if (!(a == a)) a = 1e30f;
        md = fmaxf(md, fabsf(a - b)); mr = fmaxf(mr, fabsf(b));
    }
    for (int o = 32; o > 0; o >>= 1) { md = fmaxf(md, __shfl_xor(md, o)); mr = fmaxf(mr, __shfl_xor(mr, o)); }
    if ((threadIdx.x & 63) == 0) { red[threadIdx.x >> 6] = md; red[4 + (threadIdx.x >> 6)] = mr; }
    __syncthreads();
    if (threadIdx.x == 0) {
        md = fmaxf(fmaxf(red[0], red[1]), fmaxf(red[2], red[3])); mr = fmaxf(fmaxf(red[4], red[5]), fmaxf(red[6], red[7]));
        atomicMax(res + 2 * idx, __float_as_uint(md)); atomicMax(res + 2 * idx + 1, __float_as_uint(mr));
    }
}
__global__ void encode_k(const unsigned* res, int n, int need, float* out) {
    if (threadIdx.x != 0 || blockIdx.x != 0) return;
    int minl = 9; float code = -1.f;
    for (int i = 1; i <= n; ++i) {
        const float d = __uint_as_float(res[2 * i]), r = __uint_as_float(res[2 * i + 1]);
        float rel = d / fmaxf(r, 1e-30f); if (!(rel == rel)) rel = 1.f;
        int lvl = (int)floorf(-log10f(fmaxf(rel, 1e-9f))); lvl = lvl < 0 ? 0 : (lvl > 9 ? 9 : lvl);
        if (r == 0.f) lvl = 0;
        if (lvl < need && code < 0.f) code = 100.f * (10 * i + lvl);
        minl = lvl < minl ? lvl : minl;
    }
    if (code < 0.f) code = 100.f * (90 + minl);
    out[0] = code;
}
__global__ void zero_k(float* p, size_t n) {
    for (size_t i = (size_t)blockIdx.x * blockDim.x + threadIdx.x; i < n; i += (size_t)gridDim.x * blockDim.x) p[i] = 0.f;
}
__global__ void encode2_k(const unsigned* res, int n, int need, float* out) {
    int nfail = 0;
    for (int i = 1; i <= n; ++i) {
        const float d = __uint_as_float(res[2 * i]), r = __uint_as_float(res[2 * i + 1]);
        float rel = d / fmaxf(r, 1e-30f); if (!(rel == rel)) rel = 1.f;
        int lvl = (int)floorf(-log10f(fmaxf(rel, 1e-9f))); lvl = lvl < 0 ? 0 : (lvl > 9 ? 9 : lvl);
        if (r == 0.f) lvl = 0;
        if (lvl < need) ++nfail;
    }
    const float code = out[0];
    const int M = nfail * 16800;
    for (int i = blockIdx.x * blockDim.x + threadIdx.x + 1; i < M; i += gridDim.x * blockDim.x) out[i] = code;
}
}

#ifndef DBG
#define DBG 0
#endif

extern "C" void kernel_launch(void* const* d_in, const int* in_sizes, int n_in, void* d_out, int out_size, void* d_ws, size_t ws_size, hipStream_t stream) {
    if (n_in != 23 || ws_size < WS_END) { fprintf(stderr, "kernel_launch: unexpected n_in %d / ws_size %zu\n", n_in, ws_size); return; }
    float* out = (float*)d_out;
    unsigned char* ws = (unsigned char*)d_ws;
    hipStream_t st = stream;
    static int grid = 0;
    if (grid == 0) {
        int dev = 0, cus = 0;
        if (hipGetDevice(&dev) != hipSuccess || hipDeviceGetAttribute(&cus, hipDeviceAttributeMultiprocessorCount, dev) != hipSuccess) { grid = -1; return; }
        if (hipFuncSetAttribute((const void*)mega, hipFuncAttributeMaxDynamicSharedMemorySize, LDS_BYTES) != hipSuccess) { fprintf(stderr, "hipFuncSetAttribute failed\n"); grid = -1; return; }
        int per_cu = 0;
        if (hipOccupancyMaxActiveBlocksPerMultiprocessor(&per_cu, (const void*)mega, NWAVES * 64, LDS_BYTES) != hipSuccess || per_cu < 1) fprintf(stderr, "occupancy query: %d\n", per_cu);
        (void)hipGetLastError();
        grid = cus;
    }
    if (grid < 0) return;
    (void)hipMemsetAsync(ws + WS_CTL, 0, CTL_BYTES, st);
    Args a{};
    for (int i = 0; i < 23; ++i) a.in[i] = (const float*)d_in[i];
    a.out = out; a.ws = ws; a.pad = 0;
    a.mask = (DBG > 0) ? ((2u << DBG) - 1u) : 0xffffffffu;
    hipLaunchKernelGGL(mega, dim3(grid), dim3(NWAVES * 64), LDS_BYTES, st, a);

#if DBG > 0
    const float* x = (const float*)d_in[0];
    const float* g_mix = (const float*)d_in[2];  const float* w_in = (const float*)d_in[3];
    const float* g_cq = (const float*)d_in[4];   const float* g_ckv = (const float*)d_in[5];
    const float* w_uq = (const float*)d_in[6];   const float* w_uk = (const float*)d_in[7];
    const float* w_uv = (const float*)d_in[8];   const float* w_iq = (const float*)d_in[9];
    const float* w_a = (const float*)d_in[10];   const float* g_sgu = (const float*)d_in[11];
    const float* w_sp = (const float*)d_in[12];  const float* b_sp = (const float*)d_in[13];
    const float* w_b = (const float*)d_in[14];   const float* w_o = (const float*)d_in[15];
    const float* g_ffn = (const float*)d_in[16]; const float* w_gu = (const float*)d_in[17];
    const float* w_down = (const float*)d_in[18]; const float* g_ple = (const float*)d_in[19];
    const float* w_pg = (const float*)d_in[20];  const float* w_pp = (const float*)d_in[21];
    const float* g_fin = (const float*)d_in[22]; const float* p = (const float*)d_in[1];
    (void)g_cq; (void)g_ckv; (void)w_uq; (void)w_uk; (void)w_uv; (void)w_iq; (void)w_a; (void)g_sgu; (void)w_sp; (void)b_sp; (void)w_b; (void)w_o; (void)g_ffn; (void)w_gu; (void)w_down; (void)g_ple; (void)w_pg; (void)w_pp; (void)g_fin; (void)p;
    const int EB = 256;
    auto nb = [&](size_t n) { return (unsigned)((n + EB - 1) / EB); };
    const int KA0 = S_;
    const int KA = 384;
    const int C0 = S_ + 256;
    size_t bump = WS_ARENA;
    auto alloc = [&](size_t floats) { float* r = (float*)(ws + bump); bump += ((floats * 4 + 255) / 256) * 256; return r; };
    unsigned* res = (unsigned*)alloc(64);
    float* nA = alloc((size_t)KA * D_);
    float* ckvO = alloc((size_t)KA * KVL); float* krO = alloc((size_t)KA * ROPE); float* kidxO = alloc((size_t)KA * IDIM);
    float* cq = alloc((size_t)CR * QLORA); float* widx = alloc((size_t)CR * IH); float* uv = alloc((size_t)CR * 2 * SGW); float* gates = alloc((size_t)CR * 2 * D_);
    float* rsq = alloc(CR);
    if (bump > WS_END) { fprintf(stderr, "arena overflow\n"); return; }
    float* nB = nA + (size_t)(C0 - KA0) * D_;
    hipLaunchKernelGGL(zero_k, dim3(1), dim3(64), 0, st, (float*)res, (size_t)64);
    hipLaunchKernelGGL(rmsnorm_k, dim3(KA), dim3(256), 0, st, x + (size_t)KA0 * D_, D_, nA, D_, g_mix, D_);
    gemm<0>(st, nA, D_, w_in + O_CKV, INC, ckvO, KVL, KA, KVL, D_);
    gemm<0>(st, nA, D_, w_in + O_KR, INC, krO, ROPE, KA, ROPE, D_);
    gemm<0>(st, nA, D_, w_in + O_KIDX, INC, kidxO, IDIM, KA, IDIM, D_);
    gemm<0>(st, nB, D_, w_in + O_CQ, INC, cq, QLORA, CR, QLORA, D_);
    gemm<0>(st, nB, D_, w_in + O_WIDX, INC, widx, IH, CR, IH, D_);
    gemm<0>(st, nB, D_, w_in + O_UV, INC, uv, 2 * SGW, CR, 2 * SGW, D_);
    gemm<0>(st, nB, D_, w_in + O_G, INC, gates, 2 * D_, CR, 2 * D_, D_);
#if DBG >= 2
    float* c_q = alloc((size_t)CR * QLORA); float* q = alloc((size_t)CR * NH * QHD); float* qidx = alloc((size_t)CR * IH * IDIM); float* qlat = alloc((size_t)CR * NH * KVL);
    hipLaunchKernelGGL(rmsnorm_k, dim3(KA), dim3(256), 0, st, ckvO, KVL, ckvO, KVL, g_ckv, KVL);
    hipLaunchKernelGGL(rope_k, dim3(nb((size_t)KA * 16)), dim3(EB), 0, st, krO, 1, ROPE, 0, KA, KA0);
    hipLaunchKernelGGL(rope_k, dim3(nb((size_t)KA * 16)), dim3(EB), 0, st, kidxO, 1, IDIM, 0, KA, KA0);
    hipLaunchKernelGGL(rmsnorm_k, dim3(CR), dim3(256), 0, st, cq, QLORA, c_q, QLORA, g_cq, QLORA);
    gemm<0>(st, c_q, QLORA, w_uq, NH * QHD, q, NH * QHD, CR, NH * QHD, QLORA);
    gemm<0>(st, c_q, QLORA, w_iq, IH * IDIM, qidx, IH * IDIM, CR, IH * IDIM, QLORA);
    hipLaunchKernelGGL(rope_k, dim3(nb((size_t)CR * NH * 16)), dim3(EB), 0, st, q, NH, QHD, NOPE, CR, C0);
    hipLaunchKernelGGL(rope_k, dim3(nb((size_t)CR * IH * 16)), dim3(EB), 0, st, qidx, IH, IDIM, 0, CR, C0);
    hipLaunchKernelGGL(qlat_k, dim3(CR), dim3(256), 0, st, q, w_uk, qlat);
#endif
#if DBG >= 4
    float* isc = alloc((size_t)CR * S_); int* selO = (int*)alloc((size_t)CR * TOPK); int* cntO = (int*)alloc(CR); int* selN = (int*)alloc((size_t)CR * TOPK);
    float* oa = alloc((size_t)CR * ATTW); float* vn = alloc((size_t)CR * SGW); float* sg = alloc((size_t)CR * SGW);
    if (bump > WS_END) { fprintf(stderr, "arena overflow\n"); return; }
    hipLaunchKernelGGL(isc_k<0>, dim3(CR), dim3(256), 0, st, qidx, kidxO, widx, isc, C0 - KA0);
    hipLaunchKernelGGL(topk_k, dim3(CR), dim3(256), 0, st, isc, selO, cntO, C0);
    hipLaunchKernelGGL(sel2int_k, dim3(nb((size_t)CR * TOPK)), dim3(EB), 0, st, (const u16*)(ws + WS_SEL) + (size_t)C0 * TOPK, selN, cntO, CR);
    hipLaunchKernelGGL(attn_k, dim3(CR), dim3(256), 0, st, q, w_uk, ckvO, krO, selN, cntO, w_uv, oa, C0 - KA0);
    hipLaunchKernelGGL(gelu_k, dim3(nb((size_t)CR * 2 * SGW)), dim3(EB), 0, st, uv, (size_t)CR * 2 * SGW);
    hipLaunchKernelGGL(rmsnorm_k, dim3(CR), dim3(256), 0, st, uv + SGW, 2 * SGW, vn, SGW, g_sgu, SGW);
    hipLaunchKernelGGL(sgumix_k, dim3(CR), dim3(256), 0, st, uv, vn, w_sp, b_sp, sg);
#endif
#if DBG == 5
    {
        const u16* SELn = (const u16*)(ws + WS_SEL); const u16* Sn = (const u16*)(ws + WS_S); const u16* OAn = (const u16*)(ws + WS_OA);
        hipLaunchKernelGGL(selcmp_k, dim3(CR), dim3(256), 0, st, SELn + (size_t)C0 * TOPK, selO, res, 1);
        hipLaunchKernelGGL(cmp_k<1>, dim3(CR), dim3(256), 0, st, (const void*)(Sn + (size_t)C0 * SGW), (size_t)SGW, sg, (size_t)SGW, SGW, 0, 1.0f, res, 2, (size_t)1);
        hipLaunchKernelGGL(cmp_k<1>, dim3(CR), dim3(256), 0, st, (const void*)(OAn + (size_t)C0 * ATTW), (size_t)ATTW, oa, (size_t)ATTW, ATTW, 0, 1.0f, res, 3, (size_t)1);
        hipLaunchKernelGGL(zero_k, dim3(2048), dim3(256), 0, st, out, (size_t)T_ * D_);
        hipLaunchKernelGGL(encode_k, dim3(1), dim3(64), 0, st, res, 3, 2, out);
        hipLaunchKernelGGL(encode2_k, dim3(64), dim3(256), 0, st, res, 3, 2, out);
    }
#endif
#if DBG == 3
    {
        const u16* CQn = (const u16*)(ws + WS_CQ); const u16* KVn = (const u16*)(ws + WS_KV); const u16* KIn = (const u16*)(ws + WS_KIDX); const float* WIn = (const float*)(ws + WS_WIDX);
        const u16* Qn = (const u16*)(ws + WS_Q); const u16* QIn = (const u16*)(ws + WS_QIDX);
        const size_t ro = (size_t)(C0 - KA0);
        const float QSh = 0.10206207261596575f * 1.4426950408889634f;
        hipLaunchKernelGGL(cmp_k<2>, dim3(CR), dim3(256), 0, st, (const void*)(CQn + (size_t)C0 * QLORA), (size_t)QLORA, c_q, (size_t)QLORA, QLORA, 0, 1.0f, res, 1, (size_t)1);
        hipLaunchKernelGGL(cmp_k<1>, dim3(CR), dim3(256), 0, st, (const void*)(KVn + (size_t)C0 * 288), (size_t)288, ckvO + ro * KVL, (size_t)KVL, KVL, 0, 1.0f, res, 2, (size_t)1);
        hipLaunchKernelGGL(cmp_k<1>, dim3(CR), dim3(256), 0, st, (const void*)(KVn + (size_t)C0 * 288 + 256), (size_t)288, krO + ro * ROPE, (size_t)ROPE, ROPE, 0, 1.0f, res, 3, (size_t)1);
        hipLaunchKernelGGL(cmp_k<2>, dim3(CR), dim3(256), 0, st, (const void*)(KIn + (size_t)C0 * IDIM), (size_t)IDIM, kidxO + ro * IDIM, (size_t)IDIM, IDIM, 0, 1.0f, res, 4, (size_t)1);
        hipLaunchKernelGGL(cmp_k<0>, dim3(CR), dim3(256), 0, st, (const void*)(WIn + (size_t)C0 * IH), (size_t)IH, widx, (size_t)IH, IH, 0, 1.0f / 32.0f, res, 5, (size_t)1);
        hipLaunchKernelGGL(cmp_k<1>, dim3(CR * NH), dim3(256), 0, st, (const void*)(Qn + (size_t)C0 * NH * 288), (size_t)288, qlat, (size_t)KVL, KVL, 0, QSh, res, 6, (size_t)1);
        hipLaunchKernelGGL(cmp_k<1>, dim3(CR * NH), dim3(256), 0, st, (const void*)(Qn + (size_t)C0 * NH * 288 + 256), (size_t)288, q + NOPE, (size_t)QHD, ROPE, 0, QSh, res, 7, (size_t)1);
        hipLaunchKernelGGL(cmp_k<2>, dim3(CR), dim3(256), 0, st, (const void*)(QIn + (size_t)C0 * IH * IDIM), (size_t)(IH * IDIM), qidx, (size_t)(IH * IDIM), IH * IDIM, 0, 1.0f, res, 8, (size_t)1);
        hipLaunchKernelGGL(zero_k, dim3(2048), dim3(256), 0, st, out, (size_t)T_ * D_);
        hipLaunchKernelGGL(encode_k, dim3(1), dim3(64), 0, st, res, 8, 2, out);
        hipLaunchKernelGGL(encode2_k, dim3(64), dim3(256), 0, st, res, 8, 2, out);
    }
#endif
#if DBG == 1
    {
        const u16* Gb = (const u16*)d_out; const u16* Zb = (const u16*)(ws + WS_Z); const float* RAW = (const float*)(ws + WS_RAW); const float* rowsqv = (const float*)(ws + WS_RSQV);
        const u16* N16 = (const u16*)(ws + WS_N16); const u16* WIN = (const u16*)(ws + WS_WIN);
        const size_t ro = (size_t)(C0 - KA0);
        hipLaunchKernelGGL(cmp_k<2>, dim3(CR), dim3(256), 0, st, (const void*)(N16 + (size_t)C0 * D_), (size_t)D_, nB, (size_t)D_, D_, 0, 1.0f, res, 1, (size_t)1);
        hipLaunchKernelGGL(cmp_k<2>, dim3(128), dim3(256), 0, st, (const void*)WIN, (size_t)D_, w_in + O_G, (size_t)1, D_, 0, 1.0f, res, 2, (size_t)INC);
        hipLaunchKernelGGL(cmp_k<2>, dim3(128), dim3(256), 0, st, (const void*)(WIN + (size_t)6144 * D_), (size_t)D_, w_in, (size_t)1, D_, 0, 1.0f, res, 3, (size_t)INC);
        hipLaunchKernelGGL(cmp_k<1>, dim3(CR), dim3(256), 0, st, (const void*)(Gb + (size_t)C0 * 4096), (size_t)4096, gates, (size_t)4096, 4096, 1, 1.0f, res, 4, (size_t)1);
        hipLaunchKernelGGL(cmp_k<0>, dim3(CR), dim3(256), 0, st, (const void*)(RAW + (size_t)C0 * 1024), (size_t)1024, cq, (size_t)QLORA, QLORA, 0, 1.0f, res, 6, (size_t)1);
        hipLaunchKernelGGL(cmp_k<0>, dim3(CR), dim3(256), 0, st, (const void*)(RAW + (size_t)C0 * 1024 + 512), (size_t)1024, ckvO + ro * KVL, (size_t)KVL, KVL, 0, 1.0f, res, 7, (size_t)1);
        hipLaunchKernelGGL(cmp_k<0>, dim3(CR), dim3(256), 0, st, (const void*)(RAW + (size_t)C0 * 1024 + 768), (size_t)1024, krO + ro * ROPE, (size_t)ROPE, ROPE, 0, 1.0f, res, 8, (size_t)1);
        hipLaunchKernelGGL(cmp_k<0>, dim3(CR), dim3(256), 0, st, (const void*)(RAW + (size_t)C0 * 1024 + 800), (size_t)1024, kidxO + ro * IDIM, (size_t)IDIM, IDIM, 0, 1.0f, res, 9, (size_t)1);
        hipLaunchKernelGGL(cmp_k<0>, dim3(CR), dim3(256), 0, st, (const void*)(RAW + (size_t)C0 * 1024 + 864), (size_t)1024, widx, (size_t)IH, IH, 0, 1.0f, res, 10, (size_t)1);
        hipLaunchKernelGGL(gelu_k, dim3(nb((size_t)CR * 2 * SGW)), dim3(EB), 0, st, uv, (size_t)CR * 2 * SGW);
        hipLaunchKernelGGL(cmp_k<1>, dim3(CR), dim3(256), 0, st, (const void*)(Zb + (size_t)C0 * 2048), (size_t)2048, uv, (size_t)2048, 2048, 0, 1.0f, res, 5, (size_t)1);
        hipLaunchKernelGGL(shim_row_bf16_sq, dim3(CR), dim3(256), 0, st, uv + SGW, 2 * SGW, (u16*)nA, SGW, rsq, SGW);
        hipLaunchKernelGGL(cmp_k<0>, dim3(1), dim3(256), 0, st, (const void*)(rowsqv + C0), (size_t)0, rsq, (size_t)0, CR, 0, 1.0f, res, 11, (size_t)1);
        hipLaunchKernelGGL(zero_k, dim3(2048), dim3(256), 0, st, out, (size_t)T_ * D_);
        hipLaunchKernelGGL(encode_k, dim3(1), dim3(64), 0, st, res, 11, 2, out);
        hipLaunchKernelGGL(encode2_k, dim3(64), dim3(256), 0, st, res, 11, 2, out);
    }
#endif
#endif
}
```
